# Optimizing an MI355X kernel written in HIP

```python
import math
import jax, jax.numpy as jnp
from jax import lax
import numpy as np

D_MODEL = 1024
BATCH = 8
SEQ = 4096
DEPTH = 1

GRID_W = 64
CTX_LEN = 256
S5_WIDTH = D_MODEL // 2
S5_GROUP = 16
S5_GROUPS = S5_WIDTH // S5_GROUP
S5_STATE = 64
CONV_WIDTH = D_MODEL - S5_WIDTH
CONV_K = 31
MIX_WIDTH = S5_WIDTH + CONV_WIDTH
IN_COLS = S5_WIDTH + 2 * CONV_WIDTH
D_FF = 4 * D_MODEL
EPS_RMS = 1e-6
EPS_LN = 1e-5
DT_MIN = 1e-3
DT_MAX = 1e-1

kernel_name = "hybrid_s5_conformer_prefix_dit_block"


def _rms_norm(x, g):
    xf = x.astype(jnp.float32)
    y = xf * lax.rsqrt(jnp.mean(xf * xf, axis=-1, keepdims=True) + EPS_RMS)
    return (y * g.astype(jnp.float32)).astype(x.dtype)


def _layer_norm(x, g, b):
    xf = x.astype(jnp.float32)
    mu = jnp.mean(xf, axis=-1, keepdims=True)
    var = jnp.mean(jnp.square(xf - mu), axis=-1, keepdims=True)
    return (xf - mu) * lax.rsqrt(var + EPS_LN) * g.astype(jnp.float32) + b.astype(jnp.float32)


def _modulate(x, shift, scale):
    return x * (1 + scale) + shift


def _s5_discretise(lam_re, lam_im, log_dt, b_re, b_im):
    lam_re = lam_re.astype(jnp.float32)
    lam_im = lam_im.astype(jnp.float32)
    dt = jnp.exp(log_dt.astype(jnp.float32))[..., None]
    mag = jnp.exp(lam_re * dt)
    abar_re = mag * jnp.cos(lam_im * dt)
    abar_im = mag * jnp.sin(lam_im * dt)
    den = lam_re * lam_re + lam_im * lam_im
    num_re = abar_re - 1
    f_re = (num_re * lam_re + abar_im * lam_im) / den
    f_im = (abar_im * lam_re - num_re * lam_im) / den
    b_re = b_re.astype(jnp.float32)
    b_im = b_im.astype(jnp.float32)
    bbar_re = f_re[..., None] * b_re - f_im[..., None] * b_im
    bbar_im = f_re[..., None] * b_im + f_im[..., None] * b_re
    return abar_re, abar_im, bbar_re, bbar_im


def _ccombine(e1, e2):
    a1r, a1i, b1r, b1i = e1
    a2r, a2i, b2r, b2i = e2
    return (a2r * a1r - a2i * a1i,
            a2r * a1i + a2i * a1r,
            a2r * b1r - a2i * b1i + b2r,
            a2r * b1i + a2i * b1r + b2i)


def _cscan(abar_re, abar_im, bu_re, bu_im, reverse):
    shp = (1, bu_re.shape[1]) + abar_re.shape
    a_re = jnp.broadcast_to(abar_re, shp)
    a_im = jnp.broadcast_to(abar_im, shp)
    return lax.associative_scan(_ccombine, (a_re, a_im, bu_re, bu_im), reverse=reverse, axis=1)


def _s5_readout(s_re, s_im, c_re, c_im):
    return (jnp.einsum('blgp,ghp->blgh', s_re, c_re.astype(jnp.float32))
            - jnp.einsum('blgp,ghp->blgh', s_im, c_im.astype(jnp.float32)))


def _s5_glu(y, w_glu):
    g = jax.nn.gelu(y)
    return g * jax.nn.sigmoid(g @ w_glu.astype(jnp.float32))


def _s5_mixer(u_lat, u_ctx, lam_re, lam_im, log_dt, b_re, b_im, c_re, c_im, d_skip, w_glu, need_ctx):
    abar_re, abar_im, bbar_re, bbar_im = _s5_discretise(lam_re, lam_im, log_dt, b_re, b_im)
    bsz, n_lat = u_lat.shape[0], u_lat.shape[1]
    n_ctx = u_ctx.shape[1]
    u4 = u_lat.astype(jnp.float32).reshape(bsz, n_lat, S5_GROUPS, S5_GROUP)
    uc4 = u_ctx.astype(jnp.float32).reshape(bsz, n_ctx, S5_GROUPS, S5_GROUP)
    d_f = d_skip.astype(jnp.float32)
    y = d_f * u4
    yc = d_f * uc4 if need_ctx else None
    for dirn, reverse in ((0, False), (1, True)):
        ar, ai = abar_re[dirn], abar_im[dirn]
        br, bi = bbar_re[dirn], bbar_im[dirn]
        cbu_re = jnp.einsum('bngh,gph->bngp', uc4, br)
        cbu_im = jnp.einsum('bngh,gph->bngp', uc4, bi)
        _, _, cs_re, cs_im = _cscan(ar, ai, cbu_re, cbu_im, reverse)
        end = 0 if reverse else -1
        h0_re = cs_re[:, end][:, None]
        h0_im = cs_im[:, end][:, None]
        bu_re = jnp.einsum('blgh,gph->blgp', u4, br)
        bu_im = jnp.einsum('blgh,gph->blgp', u4, bi)
        ap_re, ap_im, s_re, s_im = _cscan(ar, ai, bu_re, bu_im, reverse)
        s_re = s_re + ap_re * h0_re - ap_im * h0_im
        s_im = s_im + ap_re * h0_im + ap_im * h0_re
        y = y + _s5_readout(s_re, s_im, c_re[dirn], c_im[dirn])
        if need_ctx:
            yc = yc + _s5_readout(cs_re, cs_im, c_re[dirn], c_im[dirn])
    out = _s5_glu(y.reshape(bsz, n_lat, S5_WIDTH), w_glu).astype(u_lat.dtype)
    out_c = _s5_glu(yc.reshape(bsz, n_ctx, S5_WIDTH), w_glu).astype(u_ctx.dtype) if need_ctx else None
    return out, out_c


def _conv_module(v, gate, w_dw, b_dw, ln_g, ln_b, on_grid):
    bsz, n, ch = v.shape
    h = v * jax.nn.sigmoid(gate)
    pad = (CONV_K // 2, CONV_K // 2)
    if on_grid:
        rows = n // GRID_W
        h = lax.conv_general_dilated(
            h.reshape(bsz, rows, GRID_W, ch),
            w_dw.reshape(CONV_K, 1, 1, ch).astype(h.dtype),
            window_strides=(1, 1), padding=(pad, (0, 0)),
            dimension_numbers=('NHWC', 'HWIO', 'NHWC'), feature_group_count=ch)
        h = h.reshape(bsz, n, ch)
    else:
        h = lax.conv_general_dilated(
            h, w_dw.reshape(CONV_K, 1, ch).astype(h.dtype),
            window_strides=(1,), padding=(pad,),
            dimension_numbers=('NWC', 'WIO', 'NWC'), feature_group_count=ch)
    h = h + b_dw
    return jax.nn.silu(_layer_norm(h, ln_g, ln_b)).astype(v.dtype)


def _sq_relu_mlp(h, w1, w2):
    return jnp.square(jax.nn.relu(h @ w1)) @ w2


def setup_inputs(seed: int = 0) -> dict:
    key = jax.random.key(seed)
    ks = jax.random.split(key, 26)
    f32 = jnp.float32
    G, P, H = S5_GROUPS, S5_STATE, S5_GROUP

    def nrm(k, shape, scale):
        return jax.random.normal(k, shape, f32) * scale

    return {
        'x': nrm(ks[0], (BATCH, SEQ, D_MODEL), 1.0),
        'c': nrm(ks[1], (BATCH, D_MODEL), 1.0),
        'ctx': nrm(ks[2], (BATCH, CTX_LEN, D_MODEL), 1.0),
        'c_ctx': nrm(ks[3], (D_MODEL,), 1.0),
        'ada_w': nrm(ks[4], (DEPTH, D_MODEL, 6 * D_MODEL), 0.5 * D_MODEL ** -0.5),
        'ada_b': nrm(ks[5], (DEPTH, 6 * D_MODEL), 0.01),
        'norm1_g': 1.0 + nrm(ks[6], (DEPTH, D_MODEL), 0.02),
        'w_in': nrm(ks[7], (DEPTH, D_MODEL, IN_COLS), D_MODEL ** -0.5),
        's5_lam_re': -0.5 + nrm(ks[8], (DEPTH, 2, G, P), 0.01),
        's5_lam_im': jnp.pi * jnp.arange(P, dtype=f32) + nrm(ks[9], (DEPTH, 2, G, P), 0.01),
        's5_log_dt': jax.random.uniform(ks[10], (DEPTH, 2, G), f32, math.log(DT_MIN), math.log(DT_MAX)),
        's5_b_re': nrm(ks[11], (DEPTH, 2, G, P, H), (2 * H) ** -0.5),
        's5_b_im': nrm(ks[12], (DEPTH, 2, G, P, H), (2 * H) ** -0.5),
        's5_c_re': nrm(ks[13], (DEPTH, 2, G, H, P), P ** -0.5),
        's5_c_im': nrm(ks[14], (DEPTH, 2, G, H, P), P ** -0.5),
        's5_d': nrm(ks[15], (DEPTH, G, H), 1.0),
        's5_w_glu': nrm(ks[16], (DEPTH, S5_WIDTH, S5_WIDTH), S5_WIDTH ** -0.5),
        'conv_w': nrm(ks[17], (DEPTH, CONV_K, CONV_WIDTH), CONV_K ** -0.5),
        'conv_b': nrm(ks[18], (DEPTH, CONV_WIDTH), 0.01),
        'conv_ln_g': 1.0 + nrm(ks[19], (DEPTH, CONV_WIDTH), 0.02),
        'conv_ln_b': nrm(ks[20], (DEPTH, CONV_WIDTH), 0.01),
        'w_out': nrm(ks[21], (DEPTH, MIX_WIDTH, D_MODEL), MIX_WIDTH ** -0.5),
        'norm2_g': 1.0 + nrm(ks[22], (DEPTH, D_MODEL), 0.02),
        'mlp_w1': nrm(ks[23], (DEPTH, D_MODEL, D_FF), D_MODEL ** -0.5),
        'mlp_w2': nrm(ks[24], (DEPTH, D_FF, D_MODEL), D_FF ** -0.5),
        'final_g': 1.0 + nrm(ks[25], (D_MODEL,), 0.02),
    }


def reference(x, c, ctx, c_ctx, ada_w, ada_b, norm1_g, w_in, s5_lam_re, s5_lam_im, s5_log_dt,
              s5_b_re, s5_b_im, s5_c_re, s5_c_im, s5_d, s5_w_glu, conv_w, conv_b, conv_ln_g,
              conv_ln_b, w_out, norm2_g, mlp_w1, mlp_w2, final_g):
    h = x
    hc = ctx
    for layer in range(DEPTH):
        need_ctx = layer < DEPTH - 1
        mod = jax.nn.silu(c) @ ada_w[layer] + ada_b[layer]
        sh1, sc1, g1, sh2, sc2, g2 = jnp.split(mod[:, None, :], 6, axis=-1)
        n_cmod = 6 if need_ctx else 2
        modc = jax.nn.silu(c_ctx) @ ada_w[layer][:, :n_cmod * D_MODEL] + ada_b[layer][:n_cmod * D_MODEL]
        cmods = jnp.split(modc, n_cmod)

        a = _modulate(_rms_norm(h, norm1_g[layer]), sh1, sc1)
        ac = _modulate(_rms_norm(hc, norm1_g[layer]), cmods[1 - 1], cmods[1])
        z = a @ w_in[layer]
        zc = ac @ (w_in[layer] if need_ctx else w_in[layer][:, :S5_WIDTH])
        y_s5, yc_s5 = _s5_mixer(z[..., :S5_WIDTH], zc[..., :S5_WIDTH],
                                s5_lam_re[layer], s5_lam_im[layer], s5_log_dt[layer],
                                s5_b_re[layer], s5_b_im[layer], s5_c_re[layer], s5_c_im[layer],
                                s5_d[layer], s5_w_glu[layer], need_ctx)
        y_conv = _conv_module(z[..., S5_WIDTH:S5_WIDTH + CONV_WIDTH], z[..., S5_WIDTH + CONV_WIDTH:],
                              conv_w[layer], conv_b[layer], conv_ln_g[layer], conv_ln_b[layer], True)
        h = h + g1 * (jnp.concatenate([y_s5, y_conv], axis=-1) @ w_out[layer])

        h = h + g2 * _sq_relu_mlp(_modulate(_rms_norm(h, norm2_g[layer]), sh2, sc2),
                                  mlp_w1[layer], mlp_w2[layer])

        if need_ctx:
            csh1, csc1, cg1, csh2, csc2, cg2 = cmods
            yc_conv = _conv_module(zc[..., S5_WIDTH:S5_WIDTH + CONV_WIDTH], zc[..., S5_WIDTH + CONV_WIDTH:],
                                   conv_w[layer], conv_b[layer], conv_ln_g[layer], conv_ln_b[layer], False)
            hc = hc + cg1 * (jnp.concatenate([yc_s5, yc_conv], axis=-1) @ w_out[layer])
            hc = hc + cg2 * _sq_relu_mlp(_modulate(_rms_norm(hc, norm2_g[layer]), csh2, csc2),
                                         mlp_w1[layer], mlp_w2[layer])
    return _rms_norm(h, final_g)
```

```cpp
#include <hip/hip_runtime.h>
#include <hip/hip_cooperative_groups.h>
#include <cstdio>
#include <cstdint>
namespace cg = cooperative_groups;
#define GAS __attribute__((address_space(1)))
#define LAS __attribute__((address_space(3)))
typedef unsigned short bf16;
typedef unsigned v4u __attribute__((ext_vector_type(4)));
typedef unsigned v2u __attribute__((ext_vector_type(2)));
typedef float f32x4 __attribute__((ext_vector_type(4)));
typedef float f32x2 __attribute__((ext_vector_type(2)));
constexpr int DM = 1024, NB = 8, SEQ = 4096, NCTX = 256, ML = NB * SEQ, MC = NB * NCTX, MT = ML + MC;
constexpr int S5W = 512, CVW = 512, INC = 1536, DFF = 4096, NG = 32, NP = 64, NH = 16, CK = 31;
constexpr float EPS_RMS = 1e-6f, EPS_LN = 1e-5f;
constexpr size_t MiB = 1u << 20;
constexpr size_t WS_HID = 0;
constexpr size_t WS_A1 = 0, WS_U = 68 * MiB, WS_HC = 102 * MiB, WS_G = 134 * MiB, WS_YC = 166 * MiB;
constexpr size_t WS_H1 = 256 * MiB;
constexpr size_t WS_HS = 384 * MiB;
constexpr size_t WS_WIN = 448 * MiB, WS_WGLU = 451 * MiB, WS_WOUT = 452 * MiB, WS_W1 = 454 * MiB, WS_W2 = 462 * MiB;
constexpr size_t WS_MOD = 470 * MiB, WS_MODC = WS_MOD + 256 * 1024, WS_BIAS1 = WS_MOD + 512 * 1024;
constexpr size_t WS_SS1 = 471 * MiB;
constexpr size_t WS_AB = 473 * MiB, WS_BB = WS_AB + 64 * 1024;
constexpr size_t WS_END = 512 * MiB;
constexpr int LDS_BYTES = 139264;

struct Params {
    const float *x, *c, *ctx, *c_ctx, *ada_w, *ada_b, *norm1_g, *w_in, *lam_re, *lam_im, *log_dt, *b_re, *b_im, *c_re, *c_im, *s5_d, *w_glu,
                *conv_w, *conv_b, *ln_g, *ln_b, *w_out, *norm2_g, *w1, *w2, *final_g;
    float* out; unsigned char* ws;
};

__device__ __forceinline__ unsigned f2bf(float f) { unsigned u = __builtin_bit_cast(unsigned, f); return (u + 0x7fffu + ((u >> 16) & 1u)) >> 16; }
__device__ __forceinline__ unsigned pk2(float lo, float hi) { return f2bf(lo) | (f2bf(hi) << 16); }
__device__ __forceinline__ float bflo(unsigned w) { return __builtin_bit_cast(float, w << 16); }
__device__ __forceinline__ float bfhi(unsigned w) { return __builtin_bit_cast(float, w & 0xffff0000u); }
__device__ __forceinline__ float wave_sum(float v) {
#pragma unroll
    for (int o = 1; o < 64; o <<= 1) v += __shfl_xor(v, o);
    return v;
}
__device__ __forceinline__ float sigmoidf_(float g) { return __builtin_amdgcn_rcpf(1.0f + __expf(-g)); }
__device__ __forceinline__ float gelu_tanh(float y) {
    const float z = 0.7978845608028654f * (y + 0.044715f * y * y * y);
    const float th = 1.0f - 2.0f * __builtin_amdgcn_rcpf(1.0f + __expf(2.0f * z));
    return 0.5f * y * (1.0f + th);
}
#define LDS_WAIT() asm volatile("s_waitcnt lgkmcnt(0)" ::: "memory")

namespace pg8 {
#define PG8_LAS __attribute__((address_space(3)))
typedef unsigned short bf16_t;
typedef short bf16x8 __attribute__((ext_vector_type(8)));
typedef float f32x4 __attribute__((ext_vector_type(4)));
typedef unsigned u32x4 __attribute__((ext_vector_type(4)));
constexpr int BM = 256, BK = 64, HALF = 128, HTB = HALF * BK * 2  , STAGE_BYTES = 8 * HTB, NXCD = 8, WGM = 8;

__host__ __device__ __forceinline__ int lds_byte(int r, int c) { const int st = (r >> 4) * 2 + (c >> 5), rr = r & 15, cc = c & 31, ob = rr * 64 + cc * 2; return st * 1024 + (ob ^ (((ob >> 9) & 1) << 5)); }
__host__ __device__ __forceinline__ void stage_rc(int b, int& R, int& C) { const int st = b / 1024, sb = b % 1024, swz = sb ^ (((sb >> 9) & 1) << 5); R = (st >> 1) * 16 + swz / 64; C = (st & 1) * 32 + (swz % 64) / 2; }
__host__ __device__ __forceinline__ int perm32(int rho) { const int n = rho >> 4, i = rho & 15; return 8 * (i >> 2) + 4 * n + (i & 3); }

struct Unit { int pm, pn; };
struct Gemm { const bf16_t* A; const bf16_t* Bt; int M, N, K; };

struct StaticOrder {
    int nM, nN, nwg, G, c;
    __host__ __device__ void init(int M, int N, int G_, int c_) { nM = M / BM; nN = N / BM; nwg = nM * nN; G = G_; c = c_; }
    __host__ __device__ bool next(int i, Unit& u) const {
        const long L = (long)i * G + c; if (L >= nwg) return false;
        int wgid = (int)L; { const int q = nwg / NXCD, r = nwg % NXCD, xcd = wgid % NXCD, off = wgid / NXCD; wgid = (xcd < r ? xcd * (q + 1) : r * (q + 1) + (xcd - r) * q) + off; }
        const int nig = WGM * nN, gid = wgid / nig, fm = gid * WGM, gsz = (nM - fm) < WGM ? (nM - fm) : WGM;
        u.pm = fm + ((wgid % nig) % gsz); u.pn = (wgid % nig) / gsz; return true;
    }
    __device__ __forceinline__ void a_ready(const Unit&) const {}
    __device__ __forceinline__ void done(const Unit&) const {}
};

__device__ __forceinline__ unsigned cvt_pk_bf16(float lo, float hi) { unsigned r; asm volatile("v_cvt_pk_bf16_f32 %0, %1, %2" : "=v"(r) : "v"(lo), "v"(hi)); return r; }
typedef float f32x2 __attribute__((ext_vector_type(2)));
}
namespace pg8 {
typedef unsigned u32x4 __attribute__((ext_vector_type(4)));
typedef unsigned u32x2 __attribute__((ext_vector_type(2)));
struct EpiG1 {
    static constexpr bool PERM = true, AFTER_DRAIN = false;
    bf16_t* U; bf16_t* HC;
    __device__ __forceinline__ void operator()(const f32x4 (&acc)[2][2][4][2], const Unit& u, int wr, int wc, int fr, int fq) const {
        const int row0 = u.pm * BM + wr * 64 + fr;
        if (u.pn < 2) {
            const int col0 = u.pn * BM + wc * 32 + 8 * fq;
#pragma unroll
            for (int ai = 0; ai < 2; ++ai)
#pragma unroll
                for (int m = 0; m < 4; ++m) { bf16_t* rowp = U + (size_t)(row0 + ai * HALF + m * 16) * 512 + col0;
#pragma unroll
                    for (int bj = 0; bj < 2; ++bj) { const f32x4 v0 = acc[ai][bj][m][0], v1 = acc[ai][bj][m][1]; u32x4 w;
                        w.x = cvt_pk_bf16(v0[0], v0[1]); w.y = cvt_pk_bf16(v0[2], v0[3]); w.z = cvt_pk_bf16(v1[0], v1[1]); w.w = cvt_pk_bf16(v1[2], v1[3]);
                        *(u32x4*)(rowp + bj * HALF) = w; } }
        } else {
            const int ch0 = (u.pn - 2) * HALF + wc * 32 + 8 * fq;
#pragma unroll
            for (int ai = 0; ai < 2; ++ai)
#pragma unroll
                for (int m = 0; m < 4; ++m) { bf16_t* rowp = HC + (size_t)(row0 + ai * HALF + m * 16) * 512 + ch0; float h[8];
#pragma unroll
                    for (int n = 0; n < 2; ++n)
#pragma unroll
                        for (int j = 0; j < 4; ++j) h[n * 4 + j] = acc[ai][0][m][n][j] * sigmoidf_(acc[ai][1][m][n][j]);
                    u32x4 w; w.x = cvt_pk_bf16(h[0], h[1]); w.y = cvt_pk_bf16(h[2], h[3]); w.z = cvt_pk_bf16(h[4], h[5]); w.w = cvt_pk_bf16(h[6], h[7]);
                    *(u32x4*)rowp = w; }
        }
    }
};
struct EpiGlu {
    static constexpr bool PERM = true, AFTER_DRAIN = false;
    const bf16_t* G; bf16_t* YC;
    __device__ __forceinline__ void operator()(const f32x4 (&acc)[2][2][4][2], const Unit& u, int wr, int wc, int fr, int fq) const {
        const int row0 = u.pm * BM + wr * 64 + fr, col0 = u.pn * BM + wc * 32 + 8 * fq;
#pragma unroll
        for (int ai = 0; ai < 2; ++ai)
#pragma unroll
            for (int m = 0; m < 4; ++m) { const size_t row = (size_t)(row0 + ai * HALF + m * 16);
#pragma unroll
                for (int bj = 0; bj < 2; ++bj) { const u32x4 gv = *(const u32x4*)(G + row * 512 + col0 + bj * HALF);
                    const f32x4 v0 = acc[ai][bj][m][0], v1 = acc[ai][bj][m][1]; u32x4 w;
                    w.x = cvt_pk_bf16(bflo(gv.x) * sigmoidf_(v0[0]), bfhi(gv.x) * sigmoidf_(v0[1]));
                    w.y = cvt_pk_bf16(bflo(gv.y) * sigmoidf_(v0[2]), bfhi(gv.y) * sigmoidf_(v0[3]));
                    w.z = cvt_pk_bf16(bflo(gv.z) * sigmoidf_(v1[0]), bfhi(gv.z) * sigmoidf_(v1[1]));
                    w.w = cvt_pk_bf16(bflo(gv.w) * sigmoidf_(v1[2]), bfhi(gv.w) * sigmoidf_(v1[3]));
                    *(u32x4*)(YC + row * 1024 + col0 + bj * HALF) = w; } }
    }
};
struct EpiOut {
    static constexpr bool PERM = false, AFTER_DRAIN = false;
    const float* x; const float* mod; const float* n2g; float* H1; bf16_t* HS; float* SS1;
    __device__ __forceinline__ void operator()(const f32x4 (&acc)[2][2][4][2], const Unit& u, int wr, int wc, int fr, int fq) const {
        const int row0 = u.pm * BM + wr * 64 + fr, col0 = u.pn * BM + wc * 32 + 4 * fq;
        const int b = (u.pm * BM) >> 12;
        const float* mb = mod + (size_t)b * 6144;
        f32x4 g1v[2][2], wsv[2][2];
#pragma unroll
        for (int bj = 0; bj < 2; ++bj)
#pragma unroll
            for (int n = 0; n < 2; ++n) { const int c = col0 + bj * HALF + n * 16;
                g1v[bj][n] = *(const f32x4*)(mb + 2048 + c);
                wsv[bj][n] = *(const f32x4*)(n2g + c) * (*(const f32x4*)(mb + 4096 + c) + 1.0f); }
#pragma unroll
        for (int ai = 0; ai < 2; ++ai)
#pragma unroll
            for (int m = 0; m < 4; ++m) { const int row = row0 + ai * HALF + m * 16; const size_t off = (size_t)row * DM + col0; float ss = 0.f;
#pragma unroll
                for (int bj = 0; bj < 2; ++bj)
#pragma unroll
                    for (int n = 0; n < 2; ++n) { const size_t o = off + bj * HALF + n * 16;
                        const f32x4 h1 = *(const f32x4*)(x + o) + g1v[bj][n] * acc[ai][bj][m][n];
                        *(f32x4*)(H1 + o) = h1; ss += (h1[0] * h1[0] + h1[1] * h1[1]) + (h1[2] * h1[2] + h1[3] * h1[3]);
                        const f32x4 hs = h1 * wsv[bj][n]; u32x2 w; w.x = cvt_pk_bf16(hs[0], hs[1]); w.y = cvt_pk_bf16(hs[2], hs[3]);
                        *(u32x2*)(HS + o) = w; }
                ss += __shfl_xor(ss, 16); ss += __shfl_xor(ss, 32);
                if (fq == 0) SS1[(size_t)row * 16 + u.pn * 4 + wc] = ss; }
    }
};
struct EpiUp {
    static constexpr bool PERM = true, AFTER_DRAIN = false;
    const float* SS1; const float* bias1; bf16_t* HID;
    __device__ __forceinline__ void operator()(const f32x4 (&acc)[2][2][4][2], const Unit& u, int wr, int wc, int fr, int fq) const {
        const int row0 = u.pm * BM + wr * 64 + fr, col0 = u.pn * BM + wc * 32 + 8 * fq;
        const int b = (u.pm * BM) >> 12;
        f32x4 bv[2][2];
#pragma unroll
        for (int bj = 0; bj < 2; ++bj)
#pragma unroll
            for (int n = 0; n < 2; ++n) bv[bj][n] = *(const f32x4*)(bias1 + (size_t)b * DFF + col0 + bj * HALF + 4 * n);
#pragma unroll
        for (int ai = 0; ai < 2; ++ai)
#pragma unroll
            for (int m = 0; m < 4; ++m) { const int row = row0 + ai * HALF + m * 16;
                const f32x4* sp = (const f32x4*)(SS1 + (size_t)row * 16); const f32x4 s0 = sp[0], s1 = sp[1], s2 = sp[2], s3 = sp[3];
                const float ss = ((s0[0] + s0[1]) + (s0[2] + s0[3])) + ((s1[0] + s1[1]) + (s1[2] + s1[3])) + ((s2[0] + s2[1]) + (s2[2] + s2[3])) + ((s3[0] + s3[1]) + (s3[2] + s3[3]));
                const float rstd = rsqrtf(ss * (1.0f / DM) + EPS_RMS);
                bf16_t* rowp = HID + (size_t)row * DFF + col0;
#pragma unroll
                for (int bj = 0; bj < 2; ++bj) { f32x4 v0 = acc[ai][bj][m][0] * rstd + bv[bj][0], v1 = acc[ai][bj][m][1] * rstd + bv[bj][1];
#pragma unroll
                    for (int j = 0; j < 4; ++j) { const float a = fmaxf(v0[j], 0.f), c = fmaxf(v1[j], 0.f); v0[j] = a * a; v1[j] = c * c; }
                    u32x4 w; w.x = cvt_pk_bf16(v0[0], v0[1]); w.y = cvt_pk_bf16(v0[2], v0[3]); w.z = cvt_pk_bf16(v1[0], v1[1]); w.w = cvt_pk_bf16(v1[2], v1[3]);
                    *(u32x4*)(rowp + bj * HALF) = w; } }
    }
};
struct EpiDown {
    static constexpr bool PERM = false, AFTER_DRAIN = false;
    const float* H1; const float* mod; float* out;
    __device__ __forceinline__ void operator()(const f32x4 (&acc)[2][2][4][2], const Unit& u, int wr, int wc, int fr, int fq) const {
        const int row0 = u.pm * BM + wr * 64 + fr, col0 = u.pn * BM + wc * 32 + 4 * fq;
        const int b = (u.pm * BM) >> 12;
        const float* mb = mod + (size_t)b * 6144 + 5120;
        f32x4 g2v[2][2];
#pragma unroll
        for (int bj = 0; bj < 2; ++bj)
#pragma unroll
            for (int n = 0; n < 2; ++n) g2v[bj][n] = *(const f32x4*)(mb + col0 + bj * HALF + n * 16);
#pragma unroll
        for (int ai = 0; ai < 2; ++ai)
#pragma unroll
            for (int m = 0; m < 4; ++m) { const size_t off = (size_t)(row0 + ai * HALF + m * 16) * DM + col0;
#pragma unroll
                for (int bj = 0; bj < 2; ++bj)
#pragma unroll
                    for (int n = 0; n < 2; ++n) { const size_t o = off + bj * HALF + n * 16;
                        *(f32x4*)(out + o) = *(const f32x4*)(H1 + o) + g2v[bj][n] * acc[ai][bj][m][n]; } }
    }
};
struct G1Order {
    StaticOrder so;
    __device__ void init(int G, int c) { so.init(ML, INC, G, c); }
    __device__ bool next(int i, Unit& u) const {
        const long L = (long)i * so.G + so.c;
        if (L < so.nwg) return so.next(i, u);
        const int e = (int)(L - so.nwg); if (e >= 16) return false;
        u.pm = 128 + (e >> 1); u.pn = e & 1; return true;
    }
    __device__ __forceinline__ void a_ready(const Unit&) const {}
    __device__ __forceinline__ void done(const Unit&) const {}
};
}
namespace pg8 {
template <class Epi, class Sched, bool ALIGN_EPI = false, bool SP2 = false>
__device__ __forceinline__ void gemm_phase(PG8_LAS unsigned char* lds, const Gemm g, const Sched& S, const Epi& E) {
    const int tid = threadIdx.x, wid = __builtin_amdgcn_readfirstlane(tid >> 6), lane = tid & 63, wr = wid >> 2, wc = wid & 3, fr = lane & 15, fq = lane >> 4;
    const int K = g.K, nt = K / BK;
    unsigned voffA[2], voffB[2];
#pragma unroll
    for (int i = 0; i < 2; ++i) { int R, C; stage_rc(tid * 16 + i * 8192, R, C); const int Rb = Epi::PERM ? ((R & ~31) + perm32(R & 31)) : R;
        voffA[i] = (unsigned)(R * K + C) * 2u; voffB[i] = (unsigned)(Rb * K + C) * 2u; }
    const size_t kstep = (size_t)(BK * 2);
    const size_t hstep = (size_t)HALF * K * 2;
    const size_t tstep = 2 * hstep;
    const unsigned ldsw = (unsigned)wid * 1024u;
    const int aoff = lds_byte(wr * 64 + fr, fq * 8), boff = lds_byte(wc * 32 + fr, fq * 8);
#define PG8_SA(b, h) (((b) * 2 + (h)) * HTB)
#define PG8_SB(b, h) ((4 + (b) * 2 + (h)) * HTB)
#define PG8_STAGE(bufoff, gbase, voff) do { _Pragma("unroll") for (int _i = 0; _i < 2; ++_i) \
        __builtin_amdgcn_global_load_lds((const unsigned*)((const char*)(gbase) + (voff)[_i]), (PG8_LAS unsigned*)(lds + (bufoff) + ldsw + _i * 8192), 16, 0, 0); } while (0)
#define PG8_LDA(dst, b, h) do { _Pragma("unroll") for (int m = 0; m < 4; ++m) _Pragma("unroll") for (int k = 0; k < 2; ++k) dst[m][k] = *(const PG8_LAS bf16x8*)(lds + PG8_SA(b, h) + aoff + m * 2048 + k * 1024); } while (0)
#define PG8_LDB(dst, b, h) do { _Pragma("unroll") for (int n = 0; n < 2; ++n) _Pragma("unroll") for (int k = 0; k < 2; ++k) dst[n][k] = *(const PG8_LAS bf16x8*)(lds + PG8_SB(b, h) + boff + n * 2048 + k * 1024); } while (0)
#define PG8_MMA(ai, bj, At, Bt) do { __builtin_amdgcn_s_setprio(1); _Pragma("unroll") for (int m = 0; m < 4; ++m) _Pragma("unroll") for (int n = 0; n < 2; ++n) _Pragma("unroll") for (int k = 0; k < 2; ++k) \
        acc[ai][bj][m][n] = __builtin_amdgcn_mfma_f32_16x16x32_bf16(Bt[n][k], At[m][k], acc[ai][bj][m][n], 0, 0, 0); __builtin_amdgcn_s_setprio(0); } while (0)
#define PG8_WAIT_V(n) asm volatile("s_waitcnt vmcnt(" #n ")" ::: "memory")
#define PG8_WAIT_L(n) asm volatile("s_waitcnt lgkmcnt(" #n ")" ::: "memory")
#define PG8_BAR __builtin_amdgcn_s_barrier()
#define PG8_SCHED __builtin_amdgcn_sched_barrier(0)
    Unit cur, nxt; int ui = 0;
    if (!S.next(0, cur)) return;
    f32x4 acc[2][2][4][2];
#pragma unroll
    for (int a = 0; a < 2; ++a)
#pragma unroll
        for (int b = 0; b < 2; ++b)
#pragma unroll
            for (int m = 0; m < 4; ++m)
#pragma unroll
                for (int n = 0; n < 2; ++n) acc[a][b][m][n] = (f32x4){0.f, 0.f, 0.f, 0.f};
    bf16x8 At[4][2], B0[2][2], B1[2][2];
    const char* cA = (const char*)g.A + (size_t)cur.pm * tstep; const char* cB = (const char*)g.Bt + (size_t)cur.pn * tstep;
    S.a_ready(cur);
    if constexpr (SP2) {
        PG8_STAGE(PG8_SB(0, 0), cB, voffB); PG8_STAGE(PG8_SB(0, 1), cB + hstep, voffB); PG8_STAGE(PG8_SA(0, 0), cA, voffA); PG8_STAGE(PG8_SA(0, 1), cA + hstep, voffA);
        if (wr == 1) PG8_BAR;
        PG8_WAIT_V(2); PG8_BAR;
        PG8_STAGE(PG8_SB(1, 0), cB + kstep, voffB); PG8_STAGE(PG8_SA(1, 0), cA + kstep, voffA); PG8_STAGE(PG8_SB(1, 1), cB + hstep + kstep, voffB);
        PG8_WAIT_V(6); PG8_BAR;
    } else {
        PG8_STAGE(PG8_SB(0, 0), cB, voffB); PG8_STAGE(PG8_SA(0, 0), cA, voffA); PG8_STAGE(PG8_SB(0, 1), cB + hstep, voffB); PG8_STAGE(PG8_SA(0, 1), cA + hstep, voffA);
        if (wr == 1) PG8_BAR;
        PG8_WAIT_V(4); PG8_BAR;
        PG8_STAGE(PG8_SB(1, 0), cB + kstep, voffB); PG8_STAGE(PG8_SA(1, 0), cA + kstep, voffA); PG8_STAGE(PG8_SB(1, 1), cB + hstep + kstep, voffB);
        PG8_WAIT_V(6); PG8_BAR;
    }
    for (;;) {
        const bool has_next = S.next(ui + 1, nxt);
        const char* nA = has_next ? (const char*)g.A + (size_t)nxt.pm * tstep : cA; const char* nB = has_next ? (const char*)g.Bt + (size_t)nxt.pn * tstep : cB;
        for (int t = 0; t < nt; t += 2) {
            const bool last = (t == nt - 2);
            const char* a1 = cA + (size_t)(t + 1) * kstep;
            const char* a2 = last ? nA : cA + (size_t)(t + 2) * kstep; const char* b2 = last ? nB : cB + (size_t)(t + 2) * kstep;
            const char* a3 = a2 + kstep; const char* b3 = b2 + kstep;
            if (last && has_next) S.a_ready(nxt);
            if constexpr (SP2) {
            PG8_LDB(B0, 0, 0); PG8_LDB(B1, 0, 1); PG8_SCHED; PG8_LDA(At, 0, 0); PG8_STAGE(PG8_SA(1, 1), a1 + hstep, voffA);
            PG8_WAIT_V(8); PG8_WAIT_L(0); PG8_BAR; PG8_MMA(0, 0, At, B0); PG8_MMA(0, 1, At, B1); PG8_BAR; PG8_SCHED;
            PG8_LDA(At, 0, 1); PG8_STAGE(PG8_SB(0, 0), b2, voffB); PG8_STAGE(PG8_SB(0, 1), b2 + hstep, voffB); PG8_STAGE(PG8_SA(0, 0), a2, voffA);
            PG8_WAIT_V(8); PG8_WAIT_L(0); PG8_BAR; PG8_MMA(1, 0, At, B0); PG8_MMA(1, 1, At, B1); PG8_BAR; PG8_SCHED;
            PG8_LDB(B0, 1, 0); PG8_LDB(B1, 1, 1); PG8_SCHED; PG8_LDA(At, 1, 0); PG8_STAGE(PG8_SA(0, 1), a2 + hstep, voffA);
            PG8_WAIT_V(8); PG8_WAIT_L(0); PG8_BAR; PG8_MMA(0, 0, At, B0); PG8_MMA(0, 1, At, B1); PG8_BAR; PG8_SCHED;
            PG8_LDA(At, 1, 1); PG8_STAGE(PG8_SB(1, 0), b3, voffB); PG8_STAGE(PG8_SB(1, 1), b3 + hstep, voffB); PG8_STAGE(PG8_SA(1, 0), a3, voffA);
            PG8_WAIT_V(8); PG8_WAIT_L(0); PG8_BAR; PG8_MMA(1, 0, At, B0); PG8_MMA(1, 1, At, B1); PG8_BAR; PG8_SCHED;
            } else {
            PG8_LDB(B0, 0, 0); PG8_SCHED; PG8_LDA(At, 0, 0); PG8_STAGE(PG8_SA(1, 1), a1 + hstep, voffA);
            PG8_WAIT_L(8); PG8_BAR; PG8_WAIT_L(0); PG8_MMA(0, 0, At, B0); PG8_BAR; PG8_SCHED;
            PG8_LDB(B1, 0, 1); PG8_STAGE(PG8_SB(0, 0), b2, voffB);
            PG8_BAR; PG8_WAIT_L(0); PG8_MMA(0, 1, At, B1); PG8_BAR;
            PG8_LDA(At, 0, 1); PG8_STAGE(PG8_SA(0, 0), a2, voffA);
            PG8_BAR; PG8_WAIT_L(0); PG8_MMA(1, 0, At, B0); PG8_BAR; PG8_SCHED;
            PG8_STAGE(PG8_SB(0, 1), b2 + hstep, voffB);
            PG8_WAIT_V(6); PG8_BAR; PG8_MMA(1, 1, At, B1); PG8_BAR;
            PG8_LDB(B0, 1, 0); PG8_SCHED; PG8_LDA(At, 1, 0); PG8_STAGE(PG8_SA(0, 1), a2 + hstep, voffA);
            PG8_WAIT_L(8); PG8_BAR; PG8_WAIT_L(0); PG8_MMA(0, 0, At, B0); PG8_BAR; PG8_SCHED;
            PG8_LDB(B1, 1, 1); PG8_STAGE(PG8_SB(1, 0), b3, voffB);
            PG8_BAR; PG8_WAIT_L(0); PG8_MMA(0, 1, At, B1); PG8_BAR;
            PG8_LDA(At, 1, 1); PG8_STAGE(PG8_SA(1, 0), a3, voffA);
            PG8_BAR; PG8_WAIT_L(0); PG8_MMA(1, 0, At, B0); PG8_BAR; PG8_SCHED;
            PG8_STAGE(PG8_SB(1, 1), b3 + hstep, voffB);
            PG8_WAIT_V(6); PG8_BAR; PG8_MMA(1, 1, At, B1); PG8_BAR;
            }
        }
        if constexpr (ALIGN_EPI) { if (wr == 0) PG8_BAR; }
        if constexpr (!Epi::AFTER_DRAIN) { E(acc, cur, wr, wc, fr, fq); S.done(cur); }
        if (!has_next) break;
#pragma unroll
        for (int a = 0; a < 2; ++a)
#pragma unroll
            for (int b = 0; b < 2; ++b)
#pragma unroll
                for (int m = 0; m < 4; ++m)
#pragma unroll
                    for (int n = 0; n < 2; ++n) acc[a][b][m][n] = (f32x4){0.f, 0.f, 0.f, 0.f};
        cur = nxt; cA = nA; cB = nB; ++ui;
        if constexpr (ALIGN_EPI) { if (wr == 1) PG8_BAR; }
    }
    PG8_WAIT_V(0);
    if constexpr (!ALIGN_EPI) { if (wr == 0) PG8_BAR; }
    PG8_BAR;
    if constexpr (Epi::AFTER_DRAIN) { E.fused(acc, cur, wr, wc, fr, fq, lds, wid, lane); S.done(cur); }
#undef PG8_SA
#undef PG8_SB
#undef PG8_STAGE
#undef PG8_LDA
#undef PG8_LDB
#undef PG8_MMA
#undef PG8_WAIT_V
#undef PG8_WAIT_L
#undef PG8_BAR
#undef PG8_SCHED
}
}
__device__ __forceinline__ double dexp_(double x) {
    const double k = __builtin_rint(x * 1.4426950408889634);
    const double r = (x - k * 0.693147180369123816490e+00) - k * 1.90821492927058770002e-10;
    double t = 1.0 / 6227020800.0;
    t = t * r + 1.0 / 479001600.0; t = t * r + 1.0 / 39916800.0; t = t * r + 1.0 / 3628800.0; t = t * r + 1.0 / 362880.0; t = t * r + 1.0 / 40320.0;
    t = t * r + 1.0 / 5040.0; t = t * r + 1.0 / 720.0; t = t * r + 1.0 / 120.0; t = t * r + 1.0 / 24.0; t = t * r + 1.0 / 6.0; t = t * r + 0.5; t = t * r + 1.0; t = t * r + 1.0;
    const long long bits = (long long)(1023 + (int)k) << 52;
    return t * __builtin_bit_cast(double, bits);
}
__device__ __forceinline__ void dsincos_(double th, double& s, double& c) {
    const double k = __builtin_rint(th * 0.63661977236758134308);
    const double r = (th - k * 1.57079632673412561417e+00) - k * 6.07710050650619224932e-11;
    const double r2 = r * r;
    double ps = -1.0 / 1307674368000.0; ps = ps * r2 + 1.0 / 6227020800.0; ps = ps * r2 - 1.0 / 39916800.0; ps = ps * r2 + 1.0 / 362880.0; ps = ps * r2 - 1.0 / 5040.0; ps = ps * r2 + 1.0 / 120.0; ps = ps * r2 - 1.0 / 6.0; ps = ps * r2 + 1.0;
    const double sr = ps * r;
    double pc = 1.0 / 20922789888000.0; pc = pc * r2 - 1.0 / 87178291200.0; pc = pc * r2 + 1.0 / 479001600.0; pc = pc * r2 - 1.0 / 3628800.0; pc = pc * r2 + 1.0 / 40320.0; pc = pc * r2 - 1.0 / 720.0; pc = pc * r2 + 1.0 / 24.0; pc = pc * r2 - 0.5; pc = pc * r2 + 1.0;
    const int q = ((int)k) & 3;
    s = (q == 0) ? sr : (q == 1) ? pc : (q == 2) ? -sr : -pc;
    c = (q == 0) ? pc : (q == 1) ? -sr : (q == 2) ? -pc : sr;
}
__device__ __forceinline__ int win_dest_row(int n) {
    if (n < 512) return n;
    if (n < 1024) { const int c = n - 512; return 512 + (c >> 7) * 256 + (c & 127); }
    const int c = n - 1024; return 512 + (c >> 7) * 256 + 128 + (c & 127);
}
__device__ __forceinline__ void p0_transpose_item(const float* W, int K, int N, bf16* WT, bool perm_win, LAS float* scr, int item, int lane) {
    const int nblk = N / 32, kb = item / nblk, nb = item % nblk, k0 = 64 * kb, n0 = 32 * nb;
    const int r0 = perm_win ? win_dest_row(n0) : n0;
#pragma unroll 8
    for (int i = 0; i < 32; ++i) { const int kk = 2 * i + (lane >> 5); scr[kk * 33 + (lane & 31)] = W[(size_t)(k0 + kk) * N + n0 + (lane & 31)]; }
    LDS_WAIT();
    const int c = lane & 7;
#pragma unroll
    for (int j = 0; j < 4; ++j) { const int n = (lane >> 3) + 8 * j; const LAS float* s = scr + (8 * c) * 33 + n;
        v4u o; o.x = pk2(s[0 * 33], s[1 * 33]); o.y = pk2(s[2 * 33], s[3 * 33]); o.z = pk2(s[4 * 33], s[5 * 33]); o.w = pk2(s[6 * 33], s[7 * 33]);
        *(v4u*)(WT + (size_t)(r0 + n) * K + k0 + 8 * c) = o; }
    LDS_WAIT();
}

__device__ __forceinline__ void phase0(const Params& p, LAS unsigned char* lds, int tid, int lane, int wave, int blk, int G) {
    float* mod = (float*)(p.ws + WS_MOD); float* modc = (float*)(p.ws + WS_MODC);
    LAS float* sl = (LAS float*)lds;
    LAS float* scr = (LAS float*)(lds + 40960 + wave * 9216);
    if (blk < 96) {
        for (int e = tid; e < 9 * 1024; e += 512) { const float v = e < 8192 ? p.c[e] : p.c_ctx[e - 8192]; sl[e] = v / (1.0f + expf(-v)); }
        __syncthreads();
        if (wave == 0) {
            const int n = blk * 64 + lane;
            float acc[9];
#pragma unroll
            for (int j = 0; j < 9; ++j) acc[j] = 0.f;
            for (int k = 0; k < 1024; k += 4) {
                const float w0 = p.ada_w[(size_t)(k + 0) * 6144 + n], w1 = p.ada_w[(size_t)(k + 1) * 6144 + n], w2 = p.ada_w[(size_t)(k + 2) * 6144 + n], w3 = p.ada_w[(size_t)(k + 3) * 6144 + n];
#pragma unroll
                for (int j = 0; j < 9; ++j) { const f32x4 s = *(const LAS f32x4*)(sl + j * 1024 + k); acc[j] += (s[0] * w0 + s[1] * w1) + (s[2] * w2 + s[3] * w3); }
            }
            const float bb = p.ada_b[n];
#pragma unroll
            for (int b = 0; b < 8; ++b) mod[(size_t)b * 6144 + n] = acc[b] + bb;
            if (n < 2048) modc[n] = acc[8] + bb;
        }
    } else if (blk < 104) {
        const int e = (blk - 96) * 512 + tid, dg = e >> 6;
        const double lr = (double)p.lam_re[e], li = (double)p.lam_im[e], dt = dexp_((double)p.log_dt[dg]);
        double sn, cs; dsincos_(li * dt, sn, cs);
        const double mag = dexp_(lr * dt), ar = mag * cs, ai = mag * sn;
        const double den = lr * lr + li * li, nr = ar - 1.0;
        const double fr = (nr * lr + ai * li) / den, fi = (ai * lr - nr * li) / den;
        f32x2* AB = (f32x2*)(p.ws + WS_AB); f32x2* BB = (f32x2*)(p.ws + WS_BB);
        AB[e] = (f32x2){(float)ar, (float)ai};
#pragma unroll 4
        for (int h = 0; h < 16; ++h) { const double br = (double)p.b_re[(size_t)e * 16 + h], bi = (double)p.b_im[(size_t)e * 16 + h];
            BB[(size_t)e * 16 + h] = (f32x2){(float)(fr * br - fi * bi), (float)(fr * bi + fi * br)}; }
    }
    const int gw = blk * 8 + wave, NGW = G * 8;
    constexpr int I_IN = 16 * 48, I_GLU = 8 * 16, I_OUT = 16 * 32, I_1 = 16 * 128, I_2 = 64 * 32, NIT = I_IN + I_GLU + I_OUT + I_1 + I_2;
    for (int it = gw; it < NIT; it += NGW) {
        int r = it;
        if (r < I_IN) { p0_transpose_item(p.w_in, 1024, 1536, (bf16*)(p.ws + WS_WIN), true, scr, r, lane); continue; } r -= I_IN;
        if (r < I_GLU) { p0_transpose_item(p.w_glu, 512, 512, (bf16*)(p.ws + WS_WGLU), false, scr, r, lane); continue; } r -= I_GLU;
        if (r < I_OUT) { p0_transpose_item(p.w_out, 1024, 1024, (bf16*)(p.ws + WS_WOUT), false, scr, r, lane); continue; } r -= I_OUT;
        if (r < I_1) { p0_transpose_item(p.w1, 1024, 4096, (bf16*)(p.ws + WS_W1), false, scr, r, lane); continue; } r -= I_1;
        p0_transpose_item(p.w2, 4096, 1024, (bf16*)(p.ws + WS_W2), false, scr, r, lane);
    }
}

__device__ __forceinline__ void phase1(const Params& p, LAS unsigned char* lds, int tid, int lane, int wave, int blk, int G) {
    const float* mod = (const float*)(p.ws + WS_MOD); const float* modc = (const float*)(p.ws + WS_MODC);
    if (blk < 64) {
        const int n = blk * 64 + lane; float acc[8];
#pragma unroll
        for (int b = 0; b < 8; ++b) acc[b] = 0.f;
        for (int k = wave * 128; k < wave * 128 + 128; ++k) { const float w = p.w1[(size_t)k * DFF + n];
#pragma unroll
            for (int b = 0; b < 8; ++b) acc[b] += mod[(size_t)b * 6144 + 3072 + k] * w; }
        LAS float* red = (LAS float*)lds;
#pragma unroll
        for (int b = 0; b < 8; ++b) red[(wave * 8 + b) * 64 + lane] = acc[b];
        __syncthreads();
        { const int b = tid >> 6; float s = 0.f;
#pragma unroll
          for (int w = 0; w < 8; ++w) s += red[(w * 8 + b) * 64 + lane];
          ((float*)(p.ws + WS_BIAS1))[(size_t)b * DFF + blk * 64 + lane] = s; }
    }
    bf16* A1 = (bf16*)(p.ws + WS_A1);
    const int gw = blk * 8 + wave, NGW = G * 8;
    for (int m = gw; m < MT; m += NGW) {
        const float* xr; const float* sh; const float* sc;
        if (m < ML) { xr = p.x + (size_t)m * DM; sh = mod + (size_t)(m >> 12) * 6144; sc = sh + 1024; }
        else { xr = p.ctx + (size_t)(m - ML) * DM; sh = modc; sc = modc + 1024; }
        f32x4 v[4]; float ss = 0.f;
#pragma unroll
        for (int j = 0; j < 4; ++j) { v[j] = *(const f32x4*)(xr + 4 * lane + 256 * j); ss += (v[j][0] * v[j][0] + v[j][1] * v[j][1]) + (v[j][2] * v[j][2] + v[j][3] * v[j][3]); }
        const float rstd = rsqrtf(wave_sum(ss) * (1.0f / DM) + EPS_RMS);
#pragma unroll
        for (int j = 0; j < 4; ++j) { const int c = 4 * lane + 256 * j;
            const f32x4 g = *(const f32x4*)(p.norm1_g + c), s1 = *(const f32x4*)(sc + c), s0 = *(const f32x4*)(sh + c);
            const f32x4 o = v[j] * rstd * g * (s1 + 1.0f) + s0;
            v2u w; w.x = pk2(o[0], o[1]); w.y = pk2(o[2], o[3]);
            *(v2u*)(A1 + (size_t)m * DM + c) = w; }
    }
}

__device__ __forceinline__ void s5_naive_item(const Params& p, int item, int lane, LAS float* sc) {
    const int dir = item & 1, g = (item >> 1) & 31, b = item >> 6, dgi = dir * 32 + g;
    const f32x2* AB = (const f32x2*)(p.ws + WS_AB); const f32x2* BB = (const f32x2*)(p.ws + WS_BB);
    const bf16* U = (const bf16*)(p.ws + WS_U); float* Yd = (float*)(p.ws + WS_H1) + (size_t)dir * ML * 512;
    const f32x2 a = AB[dgi * 64 + lane];
    f32x2 bb[16];
#pragma unroll
    for (int h = 0; h < 16; ++h) bb[h] = BB[(size_t)(dgi * 64 + lane) * 16 + h];
    const int hh = lane & 15, q = lane >> 4;
    float cr[16], ci[16];
#pragma unroll
    for (int j = 0; j < 16; ++j) { cr[j] = p.c_re[(size_t)(dgi * 16 + hh) * 64 + q * 16 + j]; ci[j] = p.c_im[(size_t)(dgi * 16 + hh) * 64 + q * 16 + j]; }
    float sr = 0.f, si = 0.f;
    for (int step = 0; step < NCTX + SEQ; ++step) {
        int row; const bool lat = step >= NCTX;
        if (!lat) { const int n = dir ? (NCTX - 1 - step) : step; row = ML + b * NCTX + n; }
        else { const int t0 = step - NCTX; const int t = dir ? (SEQ - 1 - t0) : t0; row = b * SEQ + t; }
        const v4u u0 = *(const v4u*)(U + (size_t)row * 512 + g * 16), u1 = *(const v4u*)(U + (size_t)row * 512 + g * 16 + 8);
        const float uu[16] = {bflo(u0.x), bfhi(u0.x), bflo(u0.y), bfhi(u0.y), bflo(u0.z), bfhi(u0.z), bflo(u0.w), bfhi(u0.w),
                              bflo(u1.x), bfhi(u1.x), bflo(u1.y), bfhi(u1.y), bflo(u1.z), bfhi(u1.z), bflo(u1.w), bfhi(u1.w)};
        float bur = 0.f, bui = 0.f;
#pragma unroll
        for (int h = 0; h < 16; ++h) { bur += bb[h][0] * uu[h]; bui += bb[h][1] * uu[h]; }
        const float nr = a[0] * sr - a[1] * si + bur, ni = a[0] * si + a[1] * sr + bui;
        sr = nr; si = ni;
        if (lat) {
            sc[lane] = sr; sc[64 + lane] = si;
            LDS_WAIT();
            float y = 0.f;
#pragma unroll
            for (int j = 0; j < 16; j += 4) { const f32x4 xr = *(const LAS f32x4*)(sc + q * 16 + j), xi = *(const LAS f32x4*)(sc + 64 + q * 16 + j);
                y += (cr[j] * xr[0] - ci[j] * xi[0]) + (cr[j + 1] * xr[1] - ci[j + 1] * xi[1]) + (cr[j + 2] * xr[2] - ci[j + 2] * xi[2]) + (cr[j + 3] * xr[3] - ci[j + 3] * xi[3]); }
            y += __shfl_xor(y, 16); y += __shfl_xor(y, 32);
            if (lane < 16) Yd[(size_t)row * 512 + g * 16 + lane] = y;
            LDS_WAIT();
        }
    }
}

__device__ __forceinline__ void conv_item(const Params& p, const LAS float* cw, int item, int lane) {
    const bf16* HC = (const bf16*)(p.ws + WS_HC); bf16* YC = (bf16*)(p.ws + WS_YC);
    const int rb = item & 7, w = (item >> 3) & 63, b = item >> 9;
    float acc[8][8];
#pragma unroll
    for (int i = 0; i < 8; ++i)
#pragma unroll
        for (int j = 0; j < 8; ++j) acc[i][j] = 0.f;
    const size_t base = ((size_t)b * SEQ + w) * 512 + lane * 8;
#pragma unroll 1
    for (int d = -15; d <= 22; ++d) {
        const int rin = rb * 8 + d;
        if (rin >= 0 && rin < 64) {
            const v4u hv = *(const v4u*)(HC + base + (size_t)rin * 64 * 512);
            const float h[8] = {bflo(hv.x), bfhi(hv.x), bflo(hv.y), bfhi(hv.y), bflo(hv.z), bfhi(hv.z), bflo(hv.w), bfhi(hv.w)};
            const LAS float* wp = cw + (d + 22) * 512 + lane * 8;
#pragma unroll
            for (int ro = 0; ro < 8; ++ro) { const f32x4 w0 = *(const LAS f32x4*)(wp - ro * 512), w1 = *(const LAS f32x4*)(wp - ro * 512 + 4);
#pragma unroll
                for (int j = 0; j < 4; ++j) { acc[ro][j] += h[j] * w0[j]; acc[ro][4 + j] += h[4 + j] * w1[j]; } }
        }
    }
    const f32x4 cb0 = *(const f32x4*)(p.conv_b + lane * 8), cb1 = *(const f32x4*)(p.conv_b + lane * 8 + 4);
    const f32x4 lg0 = *(const f32x4*)(p.ln_g + lane * 8), lg1 = *(const f32x4*)(p.ln_g + lane * 8 + 4);
    const f32x4 lb0 = *(const f32x4*)(p.ln_b + lane * 8), lb1 = *(const f32x4*)(p.ln_b + lane * 8 + 4);
#pragma unroll
    for (int ro = 0; ro < 8; ++ro) {
        float v[8]; float s = 0.f;
#pragma unroll
        for (int j = 0; j < 4; ++j) { v[j] = acc[ro][j] + cb0[j]; v[4 + j] = acc[ro][4 + j] + cb1[j]; }
#pragma unroll
        for (int j = 0; j < 8; ++j) s += v[j];
        const float mean = wave_sum(s) * (1.0f / 512.0f); float qq = 0.f;
#pragma unroll
        for (int j = 0; j < 8; ++j) { v[j] -= mean; qq += v[j] * v[j]; }
        const float rstd = rsqrtf(wave_sum(qq) * (1.0f / 512.0f) + EPS_LN);
        float o[8];
#pragma unroll
        for (int j = 0; j < 4; ++j) { const float y0 = v[j] * rstd * lg0[j] + lb0[j], y1 = v[4 + j] * rstd * lg1[j] + lb1[j]; o[j] = y0 * sigmoidf_(y0); o[4 + j] = y1 * sigmoidf_(y1); }
        v4u ov; ov.x = pk2(o[0], o[1]); ov.y = pk2(o[2], o[3]); ov.z = pk2(o[4], o[5]); ov.w = pk2(o[6], o[7]);
        *(v4u*)(YC + ((size_t)b * SEQ + (rb * 8 + ro) * 64 + w) * 1024 + 512 + lane * 8) = ov;
    }
}

__device__ __forceinline__ void phase3_naive(const Params& p, LAS unsigned char* lds, int tid, int lane, int wave, int blk, int G) {
    LAS float* cw = (LAS float*)lds;
    for (int e = tid; e < 45 * 512; e += 512) { const int kk = e >> 9; cw[e] = (kk >= 7 && kk <= 37) ? p.conv_w[e - 7 * 512] : 0.f; }
    __syncthreads();
    if (wave < 2) {
        LAS float* sc = (LAS float*)(lds + 98304 + wave * 512);
#ifndef NO_S5
        for (int item = blk + G * wave; item < 512; item += 2 * G) s5_naive_item(p, item, lane, sc);
#endif
    } else {
#ifndef NO_CONV
        for (int item = blk * 6 + (wave - 2); item < 4096; item += G * 6) conv_item(p, cw, item, lane);
#endif
    }
}
__device__ __forceinline__ void phase3b_naive(const Params& p, int tid, int blk, int G) {
    const bf16* U = (const bf16*)(p.ws + WS_U); const float* Y0 = (const float*)(p.ws + WS_H1); const float* Y1 = Y0 + (size_t)ML * 512; bf16* Gb = (bf16*)(p.ws + WS_G);
    for (size_t e = (size_t)blk * 512 + tid; e < (size_t)ML * 64; e += (size_t)G * 512) {
        const size_t o = (e >> 6) * 512 + (e & 63) * 8; const int c0 = (int)(e & 63) * 8;
        const v4u uv = *(const v4u*)(U + o);
        const float u[8] = {bflo(uv.x), bfhi(uv.x), bflo(uv.y), bfhi(uv.y), bflo(uv.z), bfhi(uv.z), bflo(uv.w), bfhi(uv.w)};
        const f32x4 a0 = *(const f32x4*)(Y0 + o), a1 = *(const f32x4*)(Y0 + o + 4), b0 = *(const f32x4*)(Y1 + o), b1 = *(const f32x4*)(Y1 + o + 4);
        const f32x4 d0 = *(const f32x4*)(p.s5_d + c0), d1 = *(const f32x4*)(p.s5_d + c0 + 4);
        float g[8];
#pragma unroll
        for (int j = 0; j < 4; ++j) { g[j] = gelu_tanh(d0[j] * u[j] + a0[j] + b0[j]); g[4 + j] = gelu_tanh(d1[j] * u[4 + j] + a1[j] + b1[j]); }
        v4u ov; ov.x = pk2(g[0], g[1]); ov.y = pk2(g[2], g[3]); ov.z = pk2(g[4], g[5]); ov.w = pk2(g[6], g[7]);
        *(v4u*)(Gb + o) = ov;
    }
}
__device__ __forceinline__ void phase_final(const Params& p, int lane, int wave, int blk, int G) {
    const int gw = blk * 8 + wave, NGW = G * 8;
    for (int m = gw; m < ML; m += NGW) {
        float* o = p.out + (size_t)m * DM; f32x4 v[4]; float ss = 0.f;
#pragma unroll
        for (int j = 0; j < 4; ++j) { v[j] = *(const f32x4*)(o + 4 * lane + 256 * j); ss += (v[j][0] * v[j][0] + v[j][1] * v[j][1]) + (v[j][2] * v[j][2] + v[j][3] * v[j][3]); }
        const float rstd = rsqrtf(wave_sum(ss) * (1.0f / DM) + EPS_RMS);
#pragma unroll
        for (int j = 0; j < 4; ++j) { const f32x4 g = *(const f32x4*)(p.final_g + 4 * lane + 256 * j); *(f32x4*)(o + 4 * lane + 256 * j) = v[j] * rstd * g; }
    }
}

__global__ void __launch_bounds__(512, 2) fwd_kernel(Params p) {
    extern __shared__ __attribute__((aligned(16))) unsigned char lds_raw[];
    cg::grid_group grid = cg::this_grid();
    LAS unsigned char* lds = (LAS unsigned char*)lds_raw;
    const int tid = threadIdx.x, lane = tid & 63, wave = __builtin_amdgcn_readfirstlane(tid >> 6), blk = blockIdx.x, G = gridDim.x;
    unsigned char* ws = p.ws;

#ifndef NO_P0
    phase0(p, lds, tid, lane, wave, blk, G);
#endif
    grid.sync();
#ifndef NO_P1
    phase1(p, lds, tid, lane, wave, blk, G);
#endif
    grid.sync();
#ifndef NO_G1
    {
        pg8::Gemm g{(const bf16*)(ws + WS_A1), (const bf16*)(ws + WS_WIN), MT, INC, DM}; pg8::G1Order S; S.init(G, blk);
        pg8::EpiG1 E{(bf16*)(ws + WS_U), (bf16*)(ws + WS_HC)};
        pg8::gemm_phase<pg8::EpiG1, pg8::G1Order, true, true>(lds, g, S, E);
    }
#endif
    grid.sync();
#ifndef NO_P3
    phase3_naive(p, lds, tid, lane, wave, blk, G);
#endif
    grid.sync();
#ifndef NO_P3B
    phase3b_naive(p, tid, blk, G);
#endif
    grid.sync();
#ifndef NO_GLU
    {
        pg8::Gemm g{(const bf16*)(ws + WS_G), (const bf16*)(ws + WS_WGLU), ML, S5W, S5W}; pg8::StaticOrder S; S.init(ML, S5W, G, blk);
        pg8::EpiGlu E{(const bf16*)(ws + WS_G), (bf16*)(ws + WS_YC)};
        pg8::gemm_phase<pg8::EpiGlu, pg8::StaticOrder, true, true>(lds, g, S, E);
    }
#endif
    grid.sync();
#ifndef NO_OUT
    {
        pg8::Gemm g{(const bf16*)(ws + WS_YC), (const bf16*)(ws + WS_WOUT), ML, DM, DM}; pg8::StaticOrder S; S.init(ML, DM, G, blk);
        pg8::EpiOut E{p.x, (const float*)(ws + WS_MOD), p.norm2_g, (float*)(ws + WS_H1), (bf16*)(ws + WS_HS), (float*)(ws + WS_SS1)};
        pg8::gemm_phase<pg8::EpiOut, pg8::StaticOrder, true, true>(lds, g, S, E);
    }
#endif
    grid.sync();
#ifndef NO_UP
    {
        pg8::Gemm g{(const bf16*)(ws + WS_HS), (const bf16*)(ws + WS_W1), ML, DFF, DM}; pg8::StaticOrder S; S.init(ML, DFF, G, blk);
        pg8::EpiUp E{(const float*)(ws + WS_SS1), (const float*)(ws + WS_BIAS1), (bf16*)(ws + WS_HID)};
        pg8::gemm_phase<pg8::EpiUp, pg8::StaticOrder, true, true>(lds, g, S, E);
    }
#endif
    grid.sync();
#ifndef NO_DOWN
    {
        pg8::Gemm g{(const bf16*)(ws + WS_HID), (const bf16*)(ws + WS_W2), ML, DM, DFF}; pg8::StaticOrder S; S.init(ML, DM, G, blk);
        pg8::EpiDown E{(const float*)(ws + WS_H1), (const float*)(ws + WS_MOD), p.out};
        pg8::gemm_phase<pg8::EpiDown, pg8::StaticOrder, true, true>(lds, g, S, E);
    }
#endif
    grid.sync();
    phase_final(p, lane, wave, blk, G);
}

extern "C" void kernel_launch(void* const* d_in, const int* in_sizes, int n_in, void* d_out, int out_size, void* d_ws, size_t ws_size, hipStream_t stream) {
    static int grid = 0;
    if (grid == 0) {
        if (n_in != 26 || out_size != ML * DM || ws_size < WS_END) { fprintf(stderr, "kernel_launch: unexpected shapes (n_in %d out %d ws %zu)\n", n_in, out_size, ws_size); grid = -1; return; }
        int dev = 0, cus = 0, per_cu = 0;
        hipGetDevice(&dev);
        hipDeviceGetAttribute(&cus, hipDeviceAttributeMultiprocessorCount, dev);
        if (hipFuncSetAttribute((const void*)fwd_kernel, hipFuncAttributeMaxDynamicSharedMemorySize, LDS_BYTES) != hipSuccess) { fprintf(stderr, "kernel_launch: hipFuncSetAttribute failed\n"); grid = -1; return; }
        if (hipOccupancyMaxActiveBlocksPerMultiprocessor(&per_cu, (const void*)fwd_kernel, 512, LDS_BYTES) != hipSuccess || per_cu < 1) { fprintf(stderr, "kernel_launch: occupancy query says %d\n", per_cu); per_cu = 1; (void)hipGetLastError(); }
        grid = cus * per_cu;
    }
    if (grid < 0) return;
    Params p{};
    const float** f = (const float**)&p;
    for (int i = 0; i < 26; ++i) f[i] = (const float*)d_in[i];
    p.out = (float*)d_out; p.ws = (unsigned char*)d_ws;
    void* args[] = {&p};
    hipError_t e = hipLaunchCooperativeKernel((const void*)fwd_kernel, dim3(grid), dim3(512), args, LDS_BYTES, stream);
    if (e != hipSuccess) fprintf(stderr, "cooperative launch failed: %s (grid %d)\n", hipGetErrorString(e), grid);
}
```

```cpp
#include <hip/hip_runtime.h>
#include <hip/hip_cooperative_groups.h>
#include <cstdio>
#include <cstdint>
namespace cg = cooperative_groups;
#define GAS __attribute__((address_space(1)))
#define LAS __attribute__((address_space(3)))
typedef unsigned short bf16;
typedef unsigned v4u __attribute__((ext_vector_type(4)));
typedef unsigned v2u __attribute__((ext_vector_type(2)));
typedef float f32x4 __attribute__((ext_vector_type(4)));
typedef float f32x2 __attribute__((ext_vector_type(2)));
constexpr int DM = 1024, NB = 8, SEQ = 4096, NCTX = 256, ML = NB * SEQ, MC = NB * NCTX, MT = ML + MC;
constexpr int S5W = 512, CVW = 512, INC = 1536, DFF = 4096, NG = 32, NP = 64, NH = 16, CK = 31;
constexpr float EPS_RMS = 1e-6f, EPS_LN = 1e-5f;
constexpr size_t MiB = 1u << 20;
constexpr size_t WS_HID = 0;
constexpr size_t WS_A1 = 0, WS_S = 0;
constexpr size_t WS_X = 68 * MiB;
constexpr size_t WS_XC = 132 * MiB;
constexpr size_t WS_HC = 134 * MiB, WS_G = 134 * MiB;
constexpr size_t WS_YC = 166 * MiB;
constexpr size_t WS_H1 = 256 * MiB;
constexpr size_t WS_HS = 384 * MiB;
constexpr size_t WS_WIN = 448 * MiB, WS_WGLU = 451 * MiB, WS_WOUT = 452 * MiB, WS_W1 = 454 * MiB, WS_W2 = 462 * MiB;
constexpr size_t WS_MOD = 470 * MiB, WS_MODC = WS_MOD + 256 * 1024, WS_BIAS1 = WS_MOD + 512 * 1024;
constexpr size_t WS_SS1 = 471 * MiB;
constexpr size_t WS_APOW = 473 * MiB;
constexpr size_t WS_BB = 474 * MiB;
constexpr size_t WS_KT = 475 * MiB;
constexpr size_t WS_WT = 476 * MiB;
constexpr size_t WS_MET = 480 * MiB;
constexpr size_t WS_END = 512 * MiB;
constexpr int LDS_BYTES = 139264;

struct Params {
    const float *x, *c, *ctx, *c_ctx, *ada_w, *ada_b, *norm1_g, *w_in, *lam_re, *lam_im, *log_dt, *b_re, *b_im, *c_re, *c_im, *s5_d, *w_glu,
                *conv_w, *conv_b, *ln_g, *ln_b, *w_out, *norm2_g, *w1, *w2, *final_g;
    float* out; unsigned char* ws;
};

__device__ __forceinline__ unsigned f2bf(float f) { unsigned u = __builtin_bit_cast(unsigned, f); return (u + 0x7fffu + ((u >> 16) & 1u)) >> 16; }
__device__ __forceinline__ unsigned pk2(float lo, float hi) { return f2bf(lo) | (f2bf(hi) << 16); }
__device__ __forceinline__ float bflo(unsigned w) { return __builtin_bit_cast(float, w << 16); }
__device__ __forceinline__ float bfhi(unsigned w) { return __builtin_bit_cast(float, w & 0xffff0000u); }
__device__ __forceinline__ float wave_sum(float v) {
#pragma unroll
    for (int o = 1; o < 64; o <<= 1) v += __shfl_xor(v, o);
    return v;
}
__device__ __forceinline__ float sigmoidf_(float g) { return __builtin_amdgcn_rcpf(1.0f + __expf(-g)); }
__device__ __forceinline__ float gelu_tanh(float y) {
    const float z = 0.7978845608028654f * (y + 0.044715f * y * y * y);
    const float th = 1.0f - 2.0f * __builtin_amdgcn_rcpf(1.0f + __expf(2.0f * z));
    return 0.5f * y * (1.0f + th);
}
#define LDS_WAIT() asm volatile("s_waitcnt lgkmcnt(0)" ::: "memory")

namespace pg8 {
#define PG8_LAS __attribute__((address_space(3)))
typedef unsigned short bf16_t;
typedef short bf16x8 __attribute__((ext_vector_type(8)));
typedef float f32x4 __attribute__((ext_vector_type(4)));
typedef unsigned u32x4 __attribute__((ext_vector_type(4)));
constexpr int BM = 256, BK = 64, HALF = 128, HTB = HALF * BK * 2  , STAGE_BYTES = 8 * HTB, NXCD = 8, WGM = 8;

__host__ __device__ __forceinline__ int lds_byte(int r, int c) { const int st = (r >> 4) * 2 + (c >> 5), rr = r & 15, cc = c & 31, ob = rr * 64 + cc * 2; return st * 1024 + (ob ^ (((ob >> 9) & 1) << 5)); }
__host__ __device__ __forceinline__ void stage_rc(int b, int& R, int& C) { const int st = b / 1024, sb = b % 1024, swz = sb ^ (((sb >> 9) & 1) << 5); R = (st >> 1) * 16 + swz / 64; C = (st & 1) * 32 + (swz % 64) / 2; }
__host__ __device__ __forceinline__ int perm32(int rho) { const int n = rho >> 4, i = rho & 15; return 8 * (i >> 2) + 4 * n + (i & 3); }

struct Unit { int pm, pn; };
struct Gemm { const bf16_t* A; const bf16_t* Bt; int M, N, K, lda; };

struct StaticOrder {
    int nM, nN, nwg, G, c;
    __host__ __device__ void init(int M, int N, int G_, int c_) { nM = M / BM; nN = N / BM; nwg = nM * nN; G = G_; c = c_; }
    __host__ __device__ bool next(int i, Unit& u) const {
        const long L = (long)i * G + c; if (L >= nwg) return false;
        int wgid = (int)L; { const int q = nwg / NXCD, r = nwg % NXCD, xcd = wgid % NXCD, off = wgid / NXCD; wgid = (xcd < r ? xcd * (q + 1) : r * (q + 1) + (xcd - r) * q) + off; }
        const int nig = WGM * nN, gid = wgid / nig, fm = gid * WGM, gsz = (nM - fm) < WGM ? (nM - fm) : WGM;
        u.pm = fm + ((wgid % nig) % gsz); u.pn = (wgid % nig) / gsz; return true;
    }
    __device__ __forceinline__ void a_ready(const Unit&) const {}
    __device__ __forceinline__ void done(const Unit&) const {}
};

__device__ __forceinline__ unsigned cvt_pk_bf16(float lo, float hi) { unsigned r; asm volatile("v_cvt_pk_bf16_f32 %0, %1, %2" : "=v"(r) : "v"(lo), "v"(hi)); return r; }
typedef float f32x2 __attribute__((ext_vector_type(2)));
}
namespace pg8 {
typedef unsigned u32x4 __attribute__((ext_vector_type(4)));
typedef unsigned u32x2 __attribute__((ext_vector_type(2)));
struct EpiG1 {
    static constexpr bool PERM = true, AFTER_DRAIN = false;
    bf16_t* X; bf16_t* XC; bf16_t* HC;
    __device__ __forceinline__ void operator()(const f32x4 (&acc)[2][2][4][2], const Unit& u, int wr, int wc, int fr, int fq) const {
        const int row0 = u.pm * BM + wr * 64 + fr;
        if (u.pn < 2) {
            const int col0 = u.pn * BM + wc * 32 + 8 * fq;
#pragma unroll
            for (int ai = 0; ai < 2; ++ai)
#pragma unroll
                for (int m = 0; m < 4; ++m) { const int row = row0 + ai * HALF + m * 16;
#pragma unroll
                    for (int bj = 0; bj < 2; ++bj) { const int col = col0 + bj * HALF, g = col >> 4, j0 = col & 15; bf16_t* dst;
                        if (row < ML) { const int b = row >> 12, c = (row >> 4) & 255, s = row & 15; dst = X + ((size_t)((b * 32 + g) * 256 + c)) * 512 + s * 16 + j0; }
                        else { const int rr = row - ML, b = rr >> 8, c = (rr >> 4) & 15, s = rr & 15; dst = XC + ((size_t)((b * 32 + g) * 16 + c)) * 256 + s * 16 + j0; }
                        const f32x4 v0 = acc[ai][bj][m][0], v1 = acc[ai][bj][m][1]; u32x4 w;
                        w.x = cvt_pk_bf16(v0[0], v0[1]); w.y = cvt_pk_bf16(v0[2], v0[3]); w.z = cvt_pk_bf16(v1[0], v1[1]); w.w = cvt_pk_bf16(v1[2], v1[3]);
                        *(u32x4*)dst = w; } }
        } else {
            const int ch0 = (u.pn - 2) * HALF + wc * 32 + 8 * fq;
#pragma unroll
            for (int ai = 0; ai < 2; ++ai)
#pragma unroll
                for (int m = 0; m < 4; ++m) { bf16_t* rowp = HC + (size_t)(row0 + ai * HALF + m * 16) * 512 + ch0; float h[8];
#pragma unroll
                    for (int n = 0; n < 2; ++n)
#pragma unroll
                        for (int j = 0; j < 4; ++j) h[n * 4 + j] = acc[ai][0][m][n][j] * sigmoidf_(acc[ai][1][m][n][j]);
                    u32x4 w; w.x = cvt_pk_bf16(h[0], h[1]); w.y = cvt_pk_bf16(h[2], h[3]); w.z = cvt_pk_bf16(h[4], h[5]); w.w = cvt_pk_bf16(h[6], h[7]);
                    *(u32x4*)rowp = w; }
        }
    }
};
struct EpiS5A {
    static constexpr bool PERM = false, AFTER_DRAIN = false;
    float* S;
    __device__ __forceinline__ void operator()(const f32x4 (&acc)[2][2][4][2], const Unit& u, int wr, int wc, int fr, int fq) const {
        float* base = S + ((size_t)u.pm * 256 + wr * 64 + fr) * 256 + wc * 32 + 4 * fq;
#pragma unroll
        for (int ai = 0; ai < 2; ++ai)
#pragma unroll
            for (int m = 0; m < 4; ++m)
#pragma unroll
                for (int bj = 0; bj < 2; ++bj)
#pragma unroll
                    for (int n = 0; n < 2; ++n) *(f32x4*)(base + (size_t)(ai * HALF + m * 16) * 256 + bj * HALF + n * 16) = acc[ai][bj][m][n];
    }
};
struct EpiS5C {
    static constexpr bool PERM = true, AFTER_DRAIN = false;
    bf16_t* G;
    __device__ __forceinline__ void operator()(const f32x4 (&acc)[2][2][4][2], const Unit& u, int wr, int wc, int fr, int fq) const {
        const int b = u.pm >> 5, g = u.pm & 31;
#pragma unroll
        for (int ai = 0; ai < 2; ++ai)
#pragma unroll
            for (int m = 0; m < 4; ++m) { const int c = ai * HALF + wr * 64 + m * 16 + fr;
#pragma unroll
                for (int bj = 0; bj < 2; ++bj) { const int o0 = bj * HALF + wc * 32 + 8 * fq, tl = o0 >> 4, i0 = o0 & 15;
                    const f32x4 v0 = acc[ai][bj][m][0], v1 = acc[ai][bj][m][1]; u32x4 w;
                    w.x = cvt_pk_bf16(gelu_tanh(v0[0]), gelu_tanh(v0[1])); w.y = cvt_pk_bf16(gelu_tanh(v0[2]), gelu_tanh(v0[3]));
                    w.z = cvt_pk_bf16(gelu_tanh(v1[0]), gelu_tanh(v1[1])); w.w = cvt_pk_bf16(gelu_tanh(v1[2]), gelu_tanh(v1[3]));
                    *(u32x4*)(G + ((size_t)(b * SEQ + c * 16 + tl)) * 512 + g * 16 + i0) = w; } }
    }
};
struct EpiGlu {
    static constexpr bool PERM = true, AFTER_DRAIN = false;
    const bf16_t* G; bf16_t* YC;
    __device__ __forceinline__ void operator()(const f32x4 (&acc)[2][2][4][2], const Unit& u, int wr, int wc, int fr, int fq) const {
        const int row0 = u.pm * BM + wr * 64 + fr, col0 = u.pn * BM + wc * 32 + 8 * fq;
#pragma unroll
        for (int ai = 0; ai < 2; ++ai)
#pragma unroll
            for (int m = 0; m < 4; ++m) { const size_t row = (size_t)(row0 + ai * HALF + m * 16);
#pragma unroll
                for (int bj = 0; bj < 2; ++bj) { const u32x4 gv = *(const u32x4*)(G + row * 512 + col0 + bj * HALF);
                    const f32x4 v0 = acc[ai][bj][m][0], v1 = acc[ai][bj][m][1]; u32x4 w;
                    w.x = cvt_pk_bf16(bflo(gv.x) * sigmoidf_(v0[0]), bfhi(gv.x) * sigmoidf_(v0[1]));
                    w.y = cvt_pk_bf16(bflo(gv.y) * sigmoidf_(v0[2]), bfhi(gv.y) * sigmoidf_(v0[3]));
                    w.z = cvt_pk_bf16(bflo(gv.z) * sigmoidf_(v1[0]), bfhi(gv.z) * sigmoidf_(v1[1]));
                    w.w = cvt_pk_bf16(bflo(gv.w) * sigmoidf_(v1[2]), bfhi(gv.w) * sigmoidf_(v1[3]));
                    *(u32x4*)(YC + row * 1024 + col0 + bj * HALF) = w; } }
    }
};
struct EpiOut {
    static constexpr bool PERM = false, AFTER_DRAIN = false;
    const float* x; const float* mod; const float* n2g; float* H1; bf16_t* HS; float* SS1;
    __device__ __forceinline__ void operator()(const f32x4 (&acc)[2][2][4][2], const Unit& u, int wr, int wc, int fr, int fq) const {
        const int row0 = u.pm * BM + wr * 64 + fr, col0 = u.pn * BM + wc * 32 + 4 * fq;
        const int b = (u.pm * BM) >> 12;
        const float* mb = mod + (size_t)b * 6144;
        f32x4 g1v[2][2], wsv[2][2];
#pragma unroll
        for (int bj = 0; bj < 2; ++bj)
#pragma unroll
            for (int n = 0; n < 2; ++n) { const int c = col0 + bj * HALF + n * 16;
                g1v[bj][n] = *(const f32x4*)(mb + 2048 + c);
                wsv[bj][n] = *(const f32x4*)(n2g + c) * (*(const f32x4*)(mb + 4096 + c) + 1.0f); }
#pragma unroll
        for (int ai = 0; ai < 2; ++ai)
#pragma unroll
            for (int m = 0; m < 4; ++m) { const int row = row0 + ai * HALF + m * 16; const size_t off = (size_t)row * DM + col0; float ss = 0.f;
#pragma unroll
                for (int bj = 0; bj < 2; ++bj)
#pragma unroll
                    for (int n = 0; n < 2; ++n) { const size_t o = off + bj * HALF + n * 16;
                        const f32x4 h1 = *(const f32x4*)(x + o) + g1v[bj][n] * acc[ai][bj][m][n];
                        *(f32x4*)(H1 + o) = h1; ss += (h1[0] * h1[0] + h1[1] * h1[1]) + (h1[2] * h1[2] + h1[3] * h1[3]);
                        const f32x4 hs = h1 * wsv[bj][n]; u32x2 w; w.x = cvt_pk_bf16(hs[0], hs[1]); w.y = cvt_pk_bf16(hs[2], hs[3]);
                        *(u32x2*)(HS + o) = w; }
                ss += __shfl_xor(ss, 16); ss += __shfl_xor(ss, 32);
                if (fq == 0) SS1[(size_t)row * 16 + u.pn * 4 + wc] = ss; }
    }
};
struct EpiUp {
    static constexpr bool PERM = true, AFTER_DRAIN = false;
    const float* SS1; const float* bias1; bf16_t* HID;
    __device__ __forceinline__ void operator()(const f32x4 (&acc)[2][2][4][2], const Unit& u, int wr, int wc, int fr, int fq) const {
        const int row0 = u.pm * BM + wr * 64 + fr, col0 = u.pn * BM + wc * 32 + 8 * fq;
        const int b = (u.pm * BM) >> 12;
        f32x4 bv[2][2];
#pragma unroll
        for (int bj = 0; bj < 2; ++bj)
#pragma unroll
            for (int n = 0; n < 2; ++n) bv[bj][n] = *(const f32x4*)(bias1 + (size_t)b * DFF + col0 + bj * HALF + 4 * n);
#pragma unroll
        for (int ai = 0; ai < 2; ++ai)
#pragma unroll
            for (int m = 0; m < 4; ++m) { const int row = row0 + ai * HALF + m * 16;
                const f32x4* sp = (const f32x4*)(SS1 + (size_t)row * 16); const f32x4 s0 = sp[0], s1 = sp[1], s2 = sp[2], s3 = sp[3];
                const float ss = ((s0[0] + s0[1]) + (s0[2] + s0[3])) + ((s1[0] + s1[1]) + (s1[2] + s1[3])) + ((s2[0] + s2[1]) + (s2[2] + s2[3])) + ((s3[0] + s3[1]) + (s3[2] + s3[3]));
                const float rstd = rsqrtf(ss * (1.0f / DM) + EPS_RMS);
                bf16_t* rowp = HID + (size_t)row * DFF + col0;
#pragma unroll
                for (int bj = 0; bj < 2; ++bj) { f32x4 v0 = acc[ai][bj][m][0] * rstd + bv[bj][0], v1 = acc[ai][bj][m][1] * rstd + bv[bj][1];
#pragma unroll
                    for (int j = 0; j < 4; ++j) { const float a = fmaxf(v0[j], 0.f), c = fmaxf(v1[j], 0.f); v0[j] = a * a; v1[j] = c * c; }
                    u32x4 w; w.x = cvt_pk_bf16(v0[0], v0[1]); w.y = cvt_pk_bf16(v0[2], v0[3]); w.z = cvt_pk_bf16(v1[0], v1[1]); w.w = cvt_pk_bf16(v1[2], v1[3]);
                    *(u32x4*)(rowp + bj * HALF) = w; } }
    }
};
struct EpiDown {
    static constexpr bool PERM = false, AFTER_DRAIN = false;
    const float* H1; const float* mod; float* out;
    __device__ __forceinline__ void operator()(const f32x4 (&acc)[2][2][4][2], const Unit& u, int wr, int wc, int fr, int fq) const {
        const int row0 = u.pm * BM + wr * 64 + fr, col0 = u.pn * BM + wc * 32 + 4 * fq;
        const int b = (u.pm * BM) >> 12;
        const float* mb = mod + (size_t)b * 6144 + 5120;
        f32x4 g2v[2][2];
#pragma unroll
        for (int bj = 0; bj < 2; ++bj)
#pragma unroll
            for (int n = 0; n < 2; ++n) g2v[bj][n] = *(const f32x4*)(mb + col0 + bj * HALF + n * 16);
#pragma unroll
        for (int ai = 0; ai < 2; ++ai)
#pragma unroll
            for (int m = 0; m < 4; ++m) { const size_t off = (size_t)(row0 + ai * HALF + m * 16) * DM + col0;
#pragma unroll
                for (int bj = 0; bj < 2; ++bj)
#pragma unroll
                    for (int n = 0; n < 2; ++n) { const size_t o = off + bj * HALF + n * 16;
                        *(f32x4*)(out + o) = *(const f32x4*)(H1 + o) + g2v[bj][n] * acc[ai][bj][m][n]; } }
    }
};
struct G1Order {
    StaticOrder so;
    __device__ void init(int G, int c) { so.init(ML, INC, G, c); }
    __device__ bool next(int i, Unit& u) const {
        const long L = (long)i * so.G + so.c;
        if (L < so.nwg) return so.next(i, u);
        const int e = (int)(L - so.nwg); if (e >= 16) return false;
        u.pm = 128 + (e >> 1); u.pn = e & 1; return true;
    }
    __device__ __forceinline__ void a_ready(const Unit&) const {}
    __device__ __forceinline__ void done(const Unit&) const {}
};
struct ItemOrder {
    int G, c, n;
    __device__ bool next(int i, Unit& u) const { const int it = c + i * G; if (it >= n) return false; u.pm = it; u.pn = it & 31; return true; }
    __device__ __forceinline__ void a_ready(const Unit&) const {}
    __device__ __forceinline__ void done(const Unit&) const {}
};
struct OneUnit {
    int pm, pn;
    __device__ bool next(int i, Unit& u) const { if (i) return false; u.pm = pm; u.pn = pn; return true; }
    __device__ __forceinline__ void a_ready(const Unit&) const {}
    __device__ __forceinline__ void done(const Unit&) const {}
};
}
namespace pg8 {
template <class Epi, class Sched, bool ALIGN_EPI = false, bool SP2 = false>
__device__ __forceinline__ void gemm_phase(PG8_LAS unsigned char* lds, const Gemm g, const Sched& S, const Epi& E) {
    int tid_l = threadIdx.x; asm volatile("" : "+v"(tid_l));
    const int tid = tid_l, wid = __builtin_amdgcn_readfirstlane(tid >> 6), lane = tid & 63, wr = wid >> 2, wc = wid & 3, fr = lane & 15, fq = lane >> 4;
    const int K = g.K, nt = K / BK;
    unsigned voffA[2], voffB[2];
#pragma unroll
    for (int i = 0; i < 2; ++i) { int R, C; stage_rc(tid * 16 + i * 8192, R, C); const int Rb = Epi::PERM ? ((R & ~31) + perm32(R & 31)) : R;
        voffA[i] = (unsigned)(R * g.lda + C) * 2u; voffB[i] = (unsigned)(Rb * K + C) * 2u; }
    const size_t kstep = (size_t)(BK * 2);
    const size_t hstep = (size_t)HALF * K * 2; const size_t hstepA = (size_t)HALF * g.lda * 2; const size_t tstepA = 2 * hstepA;
    const size_t tstep = 2 * hstep;
    const unsigned ldsw = (unsigned)wid * 1024u;
    const int aoff = lds_byte(wr * 64 + fr, fq * 8), boff = lds_byte(wc * 32 + fr, fq * 8);
#define PG8_SA(b, h) (((b) * 2 + (h)) * HTB)
#define PG8_SB(b, h) ((4 + (b) * 2 + (h)) * HTB)
#define PG8_STAGE(bufoff, gbase, voff) do { _Pragma("unroll") for (int _i = 0; _i < 2; ++_i) \
        __builtin_amdgcn_global_load_lds((const unsigned*)((const char*)(gbase) + (voff)[_i]), (PG8_LAS unsigned*)(lds + (bufoff) + ldsw + _i * 8192), 16, 0, 0); } while (0)
#define PG8_LDA(dst, b, h) do { _Pragma("unroll") for (int m = 0; m < 4; ++m) _Pragma("unroll") for (int k = 0; k < 2; ++k) dst[m][k] = *(const PG8_LAS bf16x8*)(lds + PG8_SA(b, h) + aoff + m * 2048 + k * 1024); } while (0)
#define PG8_LDB(dst, b, h) do { _Pragma("unroll") for (int n = 0; n < 2; ++n) _Pragma("unroll") for (int k = 0; k < 2; ++k) dst[n][k] = *(const PG8_LAS bf16x8*)(lds + PG8_SB(b, h) + boff + n * 2048 + k * 1024); } while (0)
#define PG8_MMA(ai, bj, At, Bt) do { __builtin_amdgcn_s_setprio(1); _Pragma("unroll") for (int m = 0; m < 4; ++m) _Pragma("unroll") for (int n = 0; n < 2; ++n) _Pragma("unroll") for (int k = 0; k < 2; ++k) \
        acc[ai][bj][m][n] = __builtin_amdgcn_mfma_f32_16x16x32_bf16(Bt[n][k], At[m][k], acc[ai][bj][m][n], 0, 0, 0); __builtin_amdgcn_s_setprio(0); } while (0)
#define PG8_WAIT_V(n) asm volatile("s_waitcnt vmcnt(" #n ")" ::: "memory")
#define PG8_WAIT_L(n) asm volatile("s_waitcnt lgkmcnt(" #n ")" ::: "memory")
#define PG8_BAR __builtin_amdgcn_s_barrier()
#define PG8_SCHED __builtin_amdgcn_sched_barrier(0)
    Unit cur, nxt; int ui = 0;
    if (!S.next(0, cur)) return;
    f32x4 acc[2][2][4][2];
#pragma unroll
    for (int a = 0; a < 2; ++a)
#pragma unroll
        for (int b = 0; b < 2; ++b)
#pragma unroll
            for (int m = 0; m < 4; ++m)
#pragma unroll
                for (int n = 0; n < 2; ++n) acc[a][b][m][n] = (f32x4){0.f, 0.f, 0.f, 0.f};
    bf16x8 At[4][2], B0[2][2], B1[2][2];
    const char* cA = (const char*)g.A + (size_t)cur.pm * tstepA; const char* cB = (const char*)g.Bt + (size_t)cur.pn * tstep;
    S.a_ready(cur);
    if constexpr (SP2) {
        PG8_STAGE(PG8_SB(0, 0), cB, voffB); PG8_STAGE(PG8_SB(0, 1), cB + hstep, voffB); PG8_STAGE(PG8_SA(0, 0), cA, voffA); PG8_STAGE(PG8_SA(0, 1), cA + hstepA, voffA);
        if (wr == 1) PG8_BAR;
        PG8_WAIT_V(2); PG8_BAR;
        PG8_STAGE(PG8_SB(1, 0), cB + kstep, voffB); PG8_STAGE(PG8_SA(1, 0), cA + kstep, voffA); PG8_STAGE(PG8_SB(1, 1), cB + hstep + kstep, voffB);
        PG8_WAIT_V(6); PG8_BAR;
    } else {
        PG8_STAGE(PG8_SB(0, 0), cB, voffB); PG8_STAGE(PG8_SA(0, 0), cA, voffA); PG8_STAGE(PG8_SB(0, 1), cB + hstep, voffB); PG8_STAGE(PG8_SA(0, 1), cA + hstepA, voffA);
        if (wr == 1) PG8_BAR;
        PG8_WAIT_V(4); PG8_BAR;
        PG8_STAGE(PG8_SB(1, 0), cB + kstep, voffB); PG8_STAGE(PG8_SA(1, 0), cA + kstep, voffA); PG8_STAGE(PG8_SB(1, 1), cB + hstep + kstep, voffB);
        PG8_WAIT_V(6); PG8_BAR;
    }
    for (;;) {
        const bool has_next = S.next(ui + 1, nxt);
        const char* nA = has_next ? (const char*)g.A + (size_t)nxt.pm * tstepA : cA; const char* nB = has_next ? (const char*)g.Bt + (size_t)nxt.pn * tstep : cB;
        for (int t = 0; t < nt; t += 2) {
            const bool last = (t == nt - 2);
            const char* a1 = cA + (size_t)(t + 1) * kstep;
            const char* a2 = last ? nA : cA + (size_t)(t + 2) * kstep; const char* b2 = last ? nB : cB + (size_t)(t + 2) * kstep;
            const char* a3 = a2 + kstep; const char* b3 = b2 + kstep;
            if (last && has_next) S.a_ready(nxt);
            if constexpr (SP2) {
            PG8_LDB(B0, 0, 0); PG8_LDB(B1, 0, 1); PG8_SCHED; PG8_LDA(At, 0, 0); PG8_STAGE(PG8_SA(1, 1), a1 + hstepA, voffA);
            PG8_WAIT_V(8); PG8_WAIT_L(0); PG8_BAR; PG8_MMA(0, 0, At, B0); PG8_MMA(0, 1, At, B1); PG8_BAR; PG8_SCHED;
            PG8_LDA(At, 0, 1); PG8_STAGE(PG8_SB(0, 0), b2, voffB); PG8_STAGE(PG8_SB(0, 1), b2 + hstep, voffB); PG8_STAGE(PG8_SA(0, 0), a2, voffA);
            PG8_WAIT_V(8); PG8_WAIT_L(0); PG8_BAR; PG8_MMA(1, 0, At, B0); PG8_MMA(1, 1, At, B1); PG8_BAR; PG8_SCHED;
            PG8_LDB(B0, 1, 0); PG8_LDB(B1, 1, 1); PG8_SCHED; PG8_LDA(At, 1, 0); PG8_STAGE(PG8_SA(0, 1), a2 + hstepA, voffA);
            PG8_WAIT_V(8); PG8_WAIT_L(0); PG8_BAR; PG8_MMA(0, 0, At, B0); PG8_MMA(0, 1, At, B1); PG8_BAR; PG8_SCHED;
            PG8_LDA(At, 1, 1); PG8_STAGE(PG8_SB(1, 0), b3, voffB); PG8_STAGE(PG8_SB(1, 1), b3 + hstep, voffB); PG8_STAGE(PG8_SA(1, 0), a3, voffA);
            PG8_WAIT_V(8); PG8_WAIT_L(0); PG8_BAR; PG8_MMA(1, 0, At, B0); PG8_MMA(1, 1, At, B1); PG8_BAR; PG8_SCHED;
            } else {
            PG8_LDB(B0, 0, 0); PG8_SCHED; PG8_LDA(At, 0, 0); PG8_STAGE(PG8_SA(1, 1), a1 + hstepA, voffA);
            PG8_WAIT_L(8); PG8_BAR; PG8_WAIT_L(0); PG8_MMA(0, 0, At, B0); PG8_BAR; PG8_SCHED;
            PG8_LDB(B1, 0, 1); PG8_STAGE(PG8_SB(0, 0), b2, voffB);
            PG8_BAR; PG8_WAIT_L(0); PG8_MMA(0, 1, At, B1); PG8_BAR;
            PG8_LDA(At, 0, 1); PG8_STAGE(PG8_SA(0, 0), a2, voffA);
            PG8_BAR; PG8_WAIT_L(0); PG8_MMA(1, 0, At, B0); PG8_BAR; PG8_SCHED;
            PG8_STAGE(PG8_SB(0, 1), b2 + hstep, voffB);
            PG8_WAIT_V(6); PG8_BAR; PG8_MMA(1, 1, At, B1); PG8_BAR;
            PG8_LDB(B0, 1, 0); PG8_SCHED; PG8_LDA(At, 1, 0); PG8_STAGE(PG8_SA(0, 1), a2 + hstepA, voffA);
            PG8_WAIT_L(8); PG8_BAR; PG8_WAIT_L(0); PG8_MMA(0, 0, At, B0); PG8_BAR; PG8_SCHED;
            PG8_LDB(B1, 1, 1); PG8_STAGE(PG8_SB(1, 0), b3, voffB);
            PG8_BAR; PG8_WAIT_L(0); PG8_MMA(0, 1, At, B1); PG8_BAR;
            PG8_LDA(At, 1, 1); PG8_STAGE(PG8_SA(1, 0), a3, voffA);
            PG8_BAR; PG8_WAIT_L(0); PG8_MMA(1, 0, At, B0); PG8_BAR; PG8_SCHED;
            PG8_STAGE(PG8_SB(1, 1), b3 + hstep, voffB);
            PG8_WAIT_V(6); PG8_BAR; PG8_MMA(1, 1, At, B1); PG8_BAR;
            }
        }
        if constexpr (ALIGN_EPI) { if (wr == 0) PG8_BAR; }
        if constexpr (!Epi::AFTER_DRAIN) { E(acc, cur, wr, wc, fr, fq); S.done(cur); }
        if (!has_next) break;
#pragma unroll
        for (int a = 0; a < 2; ++a)
#pragma unroll
            for (int b = 0; b < 2; ++b)
#pragma unroll
                for (int m = 0; m < 4; ++m)
#pragma unroll
                    for (int n = 0; n < 2; ++n) acc[a][b][m][n] = (f32x4){0.f, 0.f, 0.f, 0.f};
        cur = nxt; cA = nA; cB = nB; ++ui;
        if constexpr (ALIGN_EPI) { if (wr == 1) PG8_BAR; }
    }
    PG8_WAIT_V(0);
    if constexpr (!ALIGN_EPI) { if (wr == 0) PG8_BAR; }
    PG8_BAR;
    if constexpr (Epi::AFTER_DRAIN) { E.fused(acc, cur, wr, wc, fr, fq, lds, wid, lane); S.done(cur); }
#undef PG8_SA
#undef PG8_SB
#undef PG8_STAGE
#undef PG8_LDA
#undef PG8_LDB
#undef PG8_MMA
#undef PG8_WAIT_V
#undef PG8_WAIT_L
#undef PG8_BAR
#undef PG8_SCHED
}
}
__device__ __forceinline__ double dexp_(double x) {
    const double k = __builtin_rint(x * 1.4426950408889634);
    const double r = (x - k * 0.693147180369123816490e+00) - k * 1.90821492927058770002e-10;
    double t = 1.0 / 6227020800.0;
    t = t * r + 1.0 / 479001600.0; t = t * r + 1.0 / 39916800.0; t = t * r + 1.0 / 3628800.0; t = t * r + 1.0 / 362880.0; t = t * r + 1.0 / 40320.0;
    t = t * r + 1.0 / 5040.0; t = t * r + 1.0 / 720.0; t = t * r + 1.0 / 120.0; t = t * r + 1.0 / 24.0; t = t * r + 1.0 / 6.0; t = t * r + 0.5; t = t * r + 1.0; t = t * r + 1.0;
    const long long bits = (long long)(1023 + (int)k) << 52;
    return t * __builtin_bit_cast(double, bits);
}
__device__ __forceinline__ void dsincos_(double th, double& s, double& c) {
    const double k = __builtin_rint(th * 0.63661977236758134308);
    const double r = (th - k * 1.57079632673412561417e+00) - k * 6.07710050650619224932e-11;
    const double r2 = r * r;
    double ps = -1.0 / 1307674368000.0; ps = ps * r2 + 1.0 / 6227020800.0; ps = ps * r2 - 1.0 / 39916800.0; ps = ps * r2 + 1.0 / 362880.0; ps = ps * r2 - 1.0 / 5040.0; ps = ps * r2 + 1.0 / 120.0; ps = ps * r2 - 1.0 / 6.0; ps = ps * r2 + 1.0;
    const double sr = ps * r;
    double pc = 1.0 / 20922789888000.0; pc = pc * r2 - 1.0 / 87178291200.0; pc = pc * r2 + 1.0 / 479001600.0; pc = pc * r2 - 1.0 / 3628800.0; pc = pc * r2 + 1.0 / 40320.0; pc = pc * r2 - 1.0 / 720.0; pc = pc * r2 + 1.0 / 24.0; pc = pc * r2 - 0.5; pc = pc * r2 + 1.0;
    const int q = ((int)k) & 3;
    s = (q == 0) ? sr : (q == 1) ? pc : (q == 2) ? -sr : -pc;
    c = (q == 0) ? pc : (q == 1) ? -sr : (q == 2) ? -pc : sr;
}
__device__ __forceinline__ int win_dest_row(int n) {
    if (n < 512) return n;
    if (n < 1024) { const int c = n - 512; return 512 + (c >> 7) * 256 + (c & 127); }
    const int c = n - 1024; return 512 + (c >> 7) * 256 + 128 + (c & 127);
}
__device__ __forceinline__ void p0_transpose_item(const float* W, int K, int N, bf16* WT, bool perm_win, LAS float* scr, int item, int lane) {
    const int nblk = N / 32, kb = item / nblk, nb = item % nblk, k0 = 64 * kb, n0 = 32 * nb;
    const int r0 = perm_win ? win_dest_row(n0) : n0;
#pragma unroll 8
    for (int i = 0; i < 32; ++i) { const int kk = 2 * i + (lane >> 5); scr[kk * 33 + (lane & 31)] = W[(size_t)(k0 + kk) * N + n0 + (lane & 31)]; }
    LDS_WAIT();
    const int c = lane & 7;
#pragma unroll
    for (int j = 0; j < 4; ++j) { const int n = (lane >> 3) + 8 * j; const LAS float* s = scr + (8 * c) * 33 + n;
        v4u o; o.x = pk2(s[0 * 33], s[1 * 33]); o.y = pk2(s[2 * 33], s[3 * 33]); o.z = pk2(s[4 * 33], s[5 * 33]); o.w = pk2(s[6 * 33], s[7 * 33]);
        *(v4u*)(WT + (size_t)(r0 + n) * K + k0 + 8 * c) = o; }
    LDS_WAIT();
}

__device__ __forceinline__ void phase0(const Params& p, LAS unsigned char* lds, int tid, int lane, int wave, int blk, int G) {
    float* mod = (float*)(p.ws + WS_MOD); float* modc = (float*)(p.ws + WS_MODC);
    LAS float* sl = (LAS float*)lds;
    LAS float* scr = (LAS float*)(lds + 57344 + wave * 9216);
    if (blk < 96) {
        for (int e = tid; e < 9 * 1024; e += 512) { const float v = e < 8192 ? p.c[e] : p.c_ctx[e - 8192]; sl[e] = v / (1.0f + expf(-v)); }
        __syncthreads();
        if (wave == 0) {
            const int n = blk * 64 + lane;
            float acc[9];
#pragma unroll
            for (int j = 0; j < 9; ++j) acc[j] = 0.f;
            for (int k = 0; k < 1024; k += 4) {
                const float w0 = p.ada_w[(size_t)(k + 0) * 6144 + n], w1 = p.ada_w[(size_t)(k + 1) * 6144 + n], w2 = p.ada_w[(size_t)(k + 2) * 6144 + n], w3 = p.ada_w[(size_t)(k + 3) * 6144 + n];
#pragma unroll
                for (int j = 0; j < 9; ++j) { const f32x4 s = *(const LAS f32x4*)(sl + j * 1024 + k); acc[j] += (s[0] * w0 + s[1] * w1) + (s[2] * w2 + s[3] * w3); }
            }
            const float bb = p.ada_b[n];
#pragma unroll
            for (int b = 0; b < 8; ++b) mod[(size_t)b * 6144 + n] = acc[b] + bb;
            if (n < 2048) modc[n] = acc[8] + bb;
        }
    } else if (blk < 128) {
        const int g = blk - 96;
        LAS f32x2* lAp = (LAS f32x2*)lds;
        LAS f32x2* lBb = lAp + 2 * 64 * 17;
        LAS f32x2* lC = lBb + 2 * 64 * 16;
        f32x2* APOW = (f32x2*)(p.ws + WS_APOW); f32x2* BB = (f32x2*)(p.ws + WS_BB); float* KT = (float*)(p.ws + WS_KT);
        if (tid < 128) {
            const int dir = tid >> 6, pp = tid & 63, dg = dir * 32 + g, e = dg * 64 + pp;
            const double lr = (double)p.lam_re[e], li = (double)p.lam_im[e], dt = dexp_((double)p.log_dt[dg]);
            double ar1 = 1.0, ai1 = 0.0;
            for (int n = 0; n <= 16; ++n) { double sn, cs; dsincos_(li * dt * (double)n, sn, cs); const double mag = dexp_(lr * dt * (double)n);
                const f32x2 ap = (f32x2){(float)(mag * cs), (float)(mag * sn)}; lAp[(dir * 64 + pp) * 17 + n] = ap; APOW[(size_t)e * 17 + n] = ap;
                if (n == 1) { ar1 = mag * cs; ai1 = mag * sn; } }
            const double den = lr * lr + li * li, nr = ar1 - 1.0;
            const double fr = (nr * lr + ai1 * li) / den, fi = (ai1 * lr - nr * li) / den;
#pragma unroll 4
            for (int h = 0; h < 16; ++h) { const double br = (double)p.b_re[(size_t)e * 16 + h], bi = (double)p.b_im[(size_t)e * 16 + h];
                const f32x2 bb = (f32x2){(float)(fr * br - fi * bi), (float)(fr * bi + fi * br)}; lBb[(dir * 64 + pp) * 16 + h] = bb; BB[(size_t)e * 16 + h] = bb; }
        }
        for (int e = tid; e < 2 * 16 * 64; e += 512) { const int dir = e >> 10, i = (e >> 6) & 15, pp = e & 63; const size_t idx = (size_t)((dir * 32 + g) * 16 + i) * 64 + pp;
            lC[e] = (f32x2){p.c_re[idx], p.c_im[idx]}; }
        __syncthreads();
        for (int e = tid; e < 2 * 16 * 256; e += 512) { const int dir = e >> 12, tau = (e >> 8) & 15, i = (e >> 4) & 15, j = e & 15; float acc = 0.f;
            for (int pp = 0; pp < 64; ++pp) { const f32x2 C = lC[(dir * 16 + i) * 64 + pp], A = lAp[(dir * 64 + pp) * 17 + tau], B = lBb[(dir * 64 + pp) * 16 + j];
                const float car = C[0] * A[0] - C[1] * A[1], cai = C[0] * A[1] + C[1] * A[0]; acc += car * B[0] - cai * B[1]; }
            KT[(size_t)((dir * 32 + g) * 16 + tau) * 256 + i * 16 + j] = acc; }
    }
    const int gw = blk * 8 + wave, NGW = G * 8;
    constexpr int I_IN = 16 * 48, I_GLU = 8 * 16, I_OUT = 16 * 32, I_1 = 16 * 128, I_2 = 64 * 32, NIT = I_IN + I_GLU + I_OUT + I_1 + I_2;
    for (int it = gw; it < NIT; it += NGW) {
        int r = it;
        if (r < I_IN) { p0_transpose_item(p.w_in, 1024, 1536, (bf16*)(p.ws + WS_WIN), true, scr, r, lane); continue; } r -= I_IN;
        if (r < I_GLU) { p0_transpose_item(p.w_glu, 512, 512, (bf16*)(p.ws + WS_WGLU), false, scr, r, lane); continue; } r -= I_GLU;
        if (r < I_OUT) { p0_transpose_item(p.w_out, 1024, 1024, (bf16*)(p.ws + WS_WOUT), false, scr, r, lane); continue; } r -= I_OUT;
        if (r < I_1) { p0_transpose_item(p.w1, 1024, 4096, (bf16*)(p.ws + WS_W1), false, scr, r, lane); continue; } r -= I_1;
        p0_transpose_item(p.w2, 4096, 1024, (bf16*)(p.ws + WS_W2), false, scr, r, lane);
    }
}

__device__ __forceinline__ void phase1(const Params& p, LAS unsigned char* lds, int tid, int lane, int wave, int blk, int G) {
    const float* mod = (const float*)(p.ws + WS_MOD); const float* modc = (const float*)(p.ws + WS_MODC);
    if (blk < 64) {
        const int n = blk * 64 + lane; float acc[8];
#pragma unroll
        for (int b = 0; b < 8; ++b) acc[b] = 0.f;
        for (int k = wave * 128; k < wave * 128 + 128; ++k) { const float w = p.w1[(size_t)k * DFF + n];
#pragma unroll
            for (int b = 0; b < 8; ++b) acc[b] += mod[(size_t)b * 6144 + 3072 + k] * w; }
        LAS float* red = (LAS float*)lds;
#pragma unroll
        for (int b = 0; b < 8; ++b) red[(wave * 8 + b) * 64 + lane] = acc[b];
        __syncthreads();
        { const int b = tid >> 6; float s = 0.f;
#pragma unroll
          for (int w = 0; w < 8; ++w) s += red[(w * 8 + b) * 64 + lane];
          ((float*)(p.ws + WS_BIAS1))[(size_t)b * DFF + blk * 64 + lane] = s; }
    }
    bf16* A1 = (bf16*)(p.ws + WS_A1);
    const int gw = blk * 8 + wave, NGW = G * 8;
    for (int m = gw; m < MT; m += NGW) {
        const float* xr; const float* sh; const float* sc;
        if (m < ML) { xr = p.x + (size_t)m * DM; sh = mod + (size_t)(m >> 12) * 6144; sc = sh + 1024; }
        else { xr = p.ctx + (size_t)(m - ML) * DM; sh = modc; sc = modc + 1024; }
        f32x4 v[4]; float ss = 0.f;
#pragma unroll
        for (int j = 0; j < 4; ++j) { v[j] = *(const f32x4*)(xr + 4 * lane + 256 * j); ss += (v[j][0] * v[j][0] + v[j][1] * v[j][1]) + (v[j][2] * v[j][2] + v[j][3] * v[j][3]); }
        const float rstd = rsqrtf(wave_sum(ss) * (1.0f / DM) + EPS_RMS);
#pragma unroll
        for (int j = 0; j < 4; ++j) { const int c = 4 * lane + 256 * j;
            const f32x4 g = *(const f32x4*)(p.norm1_g + c), s1 = *(const f32x4*)(sc + c), s0 = *(const f32x4*)(sh + c);
            const f32x4 o = v[j] * rstd * g * (s1 + 1.0f) + s0;
            v2u w; w.x = pk2(o[0], o[1]); w.y = pk2(o[2], o[3]);
            *(v2u*)(A1 + (size_t)m * DM + c) = w; }
    }
}

__device__ __forceinline__ void s5_tables(const Params& p, int tid, int blk, int G) {
    const f32x2* APOW = (const f32x2*)(p.ws + WS_APOW); const f32x2* BB = (const f32x2*)(p.ws + WS_BB); const float* KT = (const float*)(p.ws + WS_KT);
    bf16* WT = (bf16*)(p.ws + WS_WT); bf16* MET = (bf16*)(p.ws + WS_MET);
    for (int it = blk * 512 + tid; it < 262144 + 524288; it += G * 512) {
        float v[8];
        if (it < 262144) {
            const int g = it >> 13, n = (it >> 5) & 255, k0 = (it & 31) * 8, dir = n >> 7, part = (n >> 6) & 1, pp = n & 63, s = k0 >> 4, j0 = k0 & 15;
            const int e = dir ? s : 15 - s; const size_t sp = (size_t)(dir * 32 + g) * 64 + pp;
            const f32x2 A = APOW[sp * 17 + e];
#pragma unroll
            for (int jj = 0; jj < 8; ++jj) { const f32x2 B = BB[sp * 16 + j0 + jj]; v[jj] = part ? (A[0] * B[1] + A[1] * B[0]) : (A[0] * B[0] - A[1] * B[1]); }
            v4u o; o.x = pk2(v[0], v[1]); o.y = pk2(v[2], v[3]); o.z = pk2(v[4], v[5]); o.w = pk2(v[6], v[7]);
            *(v4u*)(WT + ((size_t)(g * 256 + n)) * 256 + k0) = o;
        } else {
            const int it2 = it - 262144, g = it2 >> 14, o_ = (it2 >> 6) & 255, k0 = (it2 & 63) * 8, tl = o_ >> 4, i = o_ & 15;
            if (k0 < 256) {
                const int s = k0 >> 4, j0 = k0 & 15;
#pragma unroll
                for (int jj = 0; jj < 8; ++jj) { const int j = j0 + jj; float a = 0.f;
                    if (s <= tl) a += KT[(size_t)((0 * 32 + g) * 16 + (tl - s)) * 256 + i * 16 + j];
                    if (s >= tl) a += KT[(size_t)((1 * 32 + g) * 16 + (s - tl)) * 256 + i * 16 + j];
                    if (s == tl && i == j) a += p.s5_d[g * 16 + i];
                    v[jj] = a; }
            } else {
                const int kk = k0 - 256, dir = kk >> 7, part = (kk >> 6) & 1, p0 = kk & 63, e = dir ? 16 - tl : tl + 1;
#pragma unroll
                for (int jj = 0; jj < 8; ++jj) { const int pp = p0 + jj; const size_t ci = (size_t)((dir * 32 + g) * 16 + i) * 64 + pp;
                    const float cr = p.c_re[ci], cim = p.c_im[ci]; const f32x2 A = APOW[((size_t)(dir * 32 + g) * 64 + pp) * 17 + e];
                    v[jj] = part ? -(cr * A[1] + cim * A[0]) : (cr * A[0] - cim * A[1]); }
            }
            v4u o; o.x = pk2(v[0], v[1]); o.y = pk2(v[2], v[3]); o.z = pk2(v[4], v[5]); o.w = pk2(v[6], v[7]);
            *(v4u*)(MET + ((size_t)(g * 256 + o_)) * 512 + k0) = o;
        }
    }
}

__device__ __forceinline__ void s5_scan_item(const Params& p, LAS unsigned char* lds, int item, int tid, int lane, int wave) {
    const int g = item & 31;
    const bf16* XC = (const bf16*)(p.ws + WS_XC) + (size_t)item * 16 * 256;
    const bf16* WT = (const bf16*)(p.ws + WS_WT) + (size_t)g * 256 * 256;
    const f32x2* APOW = (const f32x2*)(p.ws + WS_APOW);
    LAS float* Sc = (LAS float*)lds;
    LAS f32x2* Tseg = (LAS f32x2*)(lds + 16384);
    LAS f32x2* H0 = Tseg + 512;
    {
        f32x4 acc0 = (f32x4){0.f, 0.f, 0.f, 0.f}, acc1 = acc0; const int r = lane & 15, kg = lane >> 4;
#pragma unroll
        for (int ks = 0; ks < 8; ++ks) { const pg8::bf16x8 a = *(const pg8::bf16x8*)(XC + r * 256 + ks * 32 + kg * 8);
            const pg8::bf16x8 b0 = *(const pg8::bf16x8*)(WT + (size_t)((2 * wave) * 16 + r) * 256 + ks * 32 + kg * 8), b1 = *(const pg8::bf16x8*)(WT + (size_t)((2 * wave + 1) * 16 + r) * 256 + ks * 32 + kg * 8);
            acc0 = __builtin_amdgcn_mfma_f32_16x16x32_bf16(a, b0, acc0, 0, 0, 0); acc1 = __builtin_amdgcn_mfma_f32_16x16x32_bf16(a, b1, acc1, 0, 0, 0); }
#pragma unroll
        for (int j = 0; j < 4; ++j) { Sc[(kg * 4 + j) * 256 + (2 * wave) * 16 + r] = acc0[j]; Sc[(kg * 4 + j) * 256 + (2 * wave + 1) * 16 + r] = acc1[j]; }
    }
    __syncthreads();
    const int sp = tid & 127, dir = sp >> 6, pp = sp & 63, seg = tid >> 7;
    const f32x2 a16 = APOW[((size_t)(dir * 32 + g) * 64 + pp) * 17 + 16];
    const float* S = (const float*)(p.ws + WS_S) + (size_t)item * 65536 + dir * 128 + pp;
    {
        float hr = 0.f, hi = 0.f;
#pragma unroll 8
        for (int q = 0; q < 64; ++q) { const int c = dir ? 255 - (seg * 64 + q) : seg * 64 + q; const float sr = S[c * 256], si = S[c * 256 + 64];
            const float nr = a16[0] * hr - a16[1] * hi + sr, ni = a16[0] * hi + a16[1] * hr + si; hr = nr; hi = ni; }
        Tseg[seg * 128 + sp] = (f32x2){hr, hi};
        if (seg == 0) { float cr = 0.f, ci = 0.f;
#pragma unroll 4
            for (int q = 0; q < 16; ++q) { const int cc = dir ? 15 - q : q; const float sr = Sc[cc * 256 + dir * 128 + pp], si = Sc[cc * 256 + dir * 128 + 64 + pp];
                const float nr = a16[0] * cr - a16[1] * ci + sr, ni = a16[0] * ci + a16[1] * cr + si; cr = nr; ci = ni; }
            H0[sp] = (f32x2){cr, ci}; }
    }
    __syncthreads();
    {
        f32x2 a64 = a16;
#pragma unroll
        for (int i = 0; i < 6; ++i) a64 = (f32x2){a64[0] * a64[0] - a64[1] * a64[1], 2.f * a64[0] * a64[1]};
        f32x2 h = H0[sp];
        for (int s2 = 0; s2 < seg; ++s2) { const f32x2 T = Tseg[s2 * 128 + sp]; h = (f32x2){a64[0] * h[0] - a64[1] * h[1] + T[0], a64[0] * h[1] + a64[1] * h[0] + T[1]}; }
        bf16* Xh = (bf16*)(p.ws + WS_X) + (size_t)item * 256 * 512 + 256 + dir * 128 + pp;
        float hr = h[0], hi = h[1];
#pragma unroll 8
        for (int q = 0; q < 64; ++q) { const int c = dir ? 255 - (seg * 64 + q) : seg * 64 + q;
            Xh[(size_t)c * 512] = (bf16)f2bf(hr); Xh[(size_t)c * 512 + 64] = (bf16)f2bf(hi);
            const float sr = S[c * 256], si = S[c * 256 + 64];
            const float nr = a16[0] * hr - a16[1] * hi + sr, ni = a16[0] * hi + a16[1] * hr + si; hr = nr; hi = ni; }
    }
    asm volatile("s_waitcnt vmcnt(0)" ::: "memory");
    __syncthreads();
}

__device__ __forceinline__ void conv_item(const Params& p, const LAS float* cw, int item, int lane) {
    const bf16* HC = (const bf16*)(p.ws + WS_HC); bf16* YC = (bf16*)(p.ws + WS_YC);
    const int rb = item & 7, w = (item >> 3) & 63, b = item >> 9;
    float acc[8][8];
#pragma unroll
    for (int i = 0; i < 8; ++i)
#pragma unroll
        for (int j = 0; j < 8; ++j) acc[i][j] = 0.f;
    const size_t base = ((size_t)b * SEQ + w) * 512 + lane * 8;
#pragma unroll 1
    for (int d = -15; d <= 22; ++d) {
        const int rin = rb * 8 + d;
        if (rin >= 0 && rin < 64) {
            const v4u hv = *(const v4u*)(HC + base + (size_t)rin * 64 * 512);
            const float h[8] = {bflo(hv.x), bfhi(hv.x), bflo(hv.y), bfhi(hv.y), bflo(hv.z), bfhi(hv.z), bflo(hv.w), bfhi(hv.w)};
            const LAS float* wp = cw + (d + 22) * 512 + lane * 8;
#pragma unroll
            for (int ro = 0; ro < 8; ++ro) { const f32x4 w0 = *(const LAS f32x4*)(wp - ro * 512), w1 = *(const LAS f32x4*)(wp - ro * 512 + 4);
#pragma unroll
                for (int j = 0; j < 4; ++j) { acc[ro][j] += h[j] * w0[j]; acc[ro][4 + j] += h[4 + j] * w1[j]; } }
        }
    }
    const f32x4 cb0 = *(const f32x4*)(p.conv_b + lane * 8), cb1 = *(const f32x4*)(p.conv_b + lane * 8 + 4);
    const f32x4 lg0 = *(const f32x4*)(p.ln_g + lane * 8), lg1 = *(const f32x4*)(p.ln_g + lane * 8 + 4);
    const f32x4 lb0 = *(const f32x4*)(p.ln_b + lane * 8), lb1 = *(const f32x4*)(p.ln_b + lane * 8 + 4);
#pragma unroll
    for (int ro = 0; ro < 8; ++ro) {
        float v[8]; float s = 0.f;
#pragma unroll
        for (int j = 0; j < 4; ++j) { v[j] = acc[ro][j] + cb0[j]; v[4 + j] = acc[ro][4 + j] + cb1[j]; }
#pragma unroll
        for (int j = 0; j < 8; ++j) s += v[j];
        const float mean = wave_sum(s) * (1.0f / 512.0f); float qq = 0.f;
#pragma unroll
        for (int j = 0; j < 8; ++j) { v[j] -= mean; qq += v[j] * v[j]; }
        const float rstd = rsqrtf(wave_sum(qq) * (1.0f / 512.0f) + EPS_LN);
        float o[8];
#pragma unroll
        for (int j = 0; j < 4; ++j) { const float y0 = v[j] * rstd * lg0[j] + lb0[j], y1 = v[4 + j] * rstd * lg1[j] + lb1[j]; o[j] = y0 * sigmoidf_(y0); o[4 + j] = y1 * sigmoidf_(y1); }
        v4u ov; ov.x = pk2(o[0], o[1]); ov.y = pk2(o[2], o[3]); ov.z = pk2(o[4], o[5]); ov.w = pk2(o[6], o[7]);
        *(v4u*)(YC + ((size_t)b * SEQ + (rb * 8 + ro) * 64 + w) * 1024 + 512 + lane * 8) = ov;
    }
}

__device__ __forceinline__ void phase_conv(const Params& p, LAS unsigned char* lds, int tid, int lane, int wave, int blk, int G) {
    LAS float* cw = (LAS float*)lds;
    for (int e = tid; e < 45 * 512; e += 512) { const int kk = e >> 9; cw[e] = (kk >= 7 && kk <= 37) ? p.conv_w[e - 7 * 512] : 0.f; }
    __syncthreads();
    for (int item = blk * 8 + wave; item < 4096; item += G * 8) conv_item(p, cw, item, lane);
}
__device__ __forceinline__ void phase_final(const Params& p, int lane, int wave, int blk, int G) {
    const int gw = blk * 8 + wave, NGW = G * 8;
    for (int m = gw; m < ML; m += NGW) {
        float* o = p.out + (size_t)m * DM; f32x4 v[4]; float ss = 0.f;
#pragma unroll
        for (int j = 0; j < 4; ++j) { v[j] = *(const f32x4*)(o + 4 * lane + 256 * j); ss += (v[j][0] * v[j][0] + v[j][1] * v[j][1]) + (v[j][2] * v[j][2] + v[j][3] * v[j][3]); }
        const float rstd = rsqrtf(wave_sum(ss) * (1.0f / DM) + EPS_RMS);
#pragma unroll
        for (int j = 0; j < 4; ++j) { const f32x4 g = *(const f32x4*)(p.final_g + 4 * lane + 256 * j); *(f32x4*)(o + 4 * lane + 256 * j) = v[j] * rstd * g; }
    }
}

__global__ void __launch_bounds__(512, 2) fwd_kernel(Params p) {
    extern __shared__ __attribute__((aligned(16))) unsigned char lds_raw[];
    cg::grid_group grid = cg::this_grid();
    LAS unsigned char* lds = (LAS unsigned char*)lds_raw;
    const int blk = blockIdx.x, G = gridDim.x;
#define TL int t_ = threadIdx.x; asm volatile("" : "+v"(t_)); const int tid = t_, lane = t_ & 63, wave = __builtin_amdgcn_readfirstlane(t_ >> 6); (void)tid; (void)lane; (void)wave;
    unsigned char* ws = p.ws;

#ifndef NO_P0
    { TL phase0(p, lds, tid, lane, wave, blk, G); }
#endif
    grid.sync();
#ifndef NO_P1
    { TL phase1(p, lds, tid, lane, wave, blk, G); }
    { TL s5_tables(p, tid, blk, G); }
#endif
    grid.sync();
#ifndef NO_G1
    {
        pg8::Gemm g{(const bf16*)(ws + WS_A1), (const bf16*)(ws + WS_WIN), MT, INC, DM, DM}; pg8::G1Order S; S.init(G, blk);
        pg8::EpiG1 E{(bf16*)(ws + WS_X), (bf16*)(ws + WS_XC), (bf16*)(ws + WS_HC)};
        pg8::gemm_phase<pg8::EpiG1, pg8::G1Order, true, true>(lds, g, S, E);
    }
#endif
    grid.sync();
    {
        pg8::Gemm g{(const bf16*)(ws + WS_X), (const bf16*)(ws + WS_WT), 65536, 256, 256, 512}; pg8::ItemOrder S{G, blk, 256};
        pg8::EpiS5A E{(float*)(ws + WS_S)};
        pg8::gemm_phase<pg8::EpiS5A, pg8::ItemOrder, true, true>(lds, g, S, E);
    }
    { TL phase_conv(p, lds, tid, lane, wave, blk, G); }
    grid.sync();
    for (int item = blk; item < 256; item += G) {
        { TL s5_scan_item(p, lds, item, tid, lane, wave); }
        pg8::Gemm g{(const bf16*)(ws + WS_X), (const bf16*)(ws + WS_MET), 65536, 256, 512, 512}; pg8::OneUnit S{item, item & 31};
        pg8::EpiS5C E{(bf16*)(ws + WS_G)};
        pg8::gemm_phase<pg8::EpiS5C, pg8::OneUnit, true, true>(lds, g, S, E);
    }
    grid.sync();
#ifndef NO_GLU
    {
        pg8::Gemm g{(const bf16*)(ws + WS_G), (const bf16*)(ws + WS_WGLU), ML, S5W, S5W, S5W}; pg8::StaticOrder S; S.init(ML, S5W, G, blk);
        pg8::EpiGlu E{(const bf16*)(ws + WS_G), (bf16*)(ws + WS_YC)};
        pg8::gemm_phase<pg8::EpiGlu, pg8::StaticOrder, true, true>(lds, g, S, E);
    }
#endif
    grid.sync();
#ifndef NO_OUT
    {
        pg8::Gemm g{(const bf16*)(ws + WS_YC), (const bf16*)(ws + WS_WOUT), ML, DM, DM, DM}; pg8::StaticOrder S; S.init(ML, DM, G, blk);
        pg8::EpiOut E{p.x, (const float*)(ws + WS_MOD), p.norm2_g, (float*)(ws + WS_H1), (bf16*)(ws + WS_HS), (float*)(ws + WS_SS1)};
        pg8::gemm_phase<pg8::EpiOut, pg8::StaticOrder, true, true>(lds, g, S, E);
    }
#endif
    grid.sync();
#ifndef NO_UP
    {
        pg8::Gemm g{(const bf16*)(ws + WS_HS), (const bf16*)(ws + WS_W1), ML, DFF, DM, DM}; pg8::StaticOrder S; S.init(ML, DFF, G, blk);
        pg8::EpiUp E{(const float*)(ws + WS_SS1), (const float*)(ws + WS_BIAS1), (bf16*)(ws + WS_HID)};
        pg8::gemm_phase<pg8::EpiUp, pg8::StaticOrder, true, true>(lds, g, S, E);
    }
#endif
    grid.sync();
#ifndef NO_DOWN
    {
        pg8::Gemm g{(const bf16*)(ws + WS_HID), (const bf16*)(ws + WS_W2), ML, DM, DFF, DFF}; pg8::StaticOrder S; S.init(ML, DM, G, blk);
        pg8::EpiDown E{(const float*)(ws + WS_H1), (const float*)(ws + WS_MOD), p.out};
        pg8::gemm_phase<pg8::EpiDown, pg8::StaticOrder, true, true>(lds, g, S, E);
    }
#endif
    grid.sync();
    { TL phase_final(p, lane, wave, blk, G); }
}

extern "C" void kernel_launch(void* const* d_in, const int* in_sizes, int n_in, void* d_out, int out_size, void* d_ws, size_t ws_size, hipStream_t stream) {
    static int grid = 0;
    if (grid == 0) {
        if (n_in != 26 || out_size != ML * DM || ws_size < WS_END) { fprintf(stderr, "kernel_launch: unexpected shapes (n_in %d out %d ws %zu)\n", n_in, out_size, ws_size); grid = -1; return; }
        int dev = 0, cus = 0, per_cu = 0;
        hipGetDevice(&dev);
        hipDeviceGetAttribute(&cus, hipDeviceAttributeMultiprocessorCount, dev);
        if (hipFuncSetAttribute((const void*)fwd_kernel, hipFuncAttributeMaxDynamicSharedMemorySize, LDS_BYTES) != hipSuccess) { fprintf(stderr, "kernel_launch: hipFuncSetAttribute failed\n"); grid = -1; return; }
        if (hipOccupancyMaxActiveBlocksPerMultiprocessor(&per_cu, (const void*)fwd_kernel, 512, LDS_BYTES) != hipSuccess || per_cu < 1) { fprintf(stderr, "kernel_launch: occupancy query says %d\n", per_cu); per_cu = 1; (void)hipGetLastError(); }
        grid = cus * per_cu;
    }
    if (grid < 0) return;
    Params p{};
    const float** f = (const float**)&p;
    for (int i = 0; i < 26; ++i) f[i] = (const float*)d_in[i];
    p.out = (float*)d_out; p.ws = (unsigned char*)d_ws;
    void* args[] = {&p};
    hipError_t e = hipLaunchCooperativeKernel((const void*)fwd_kernel, dim3(grid), dim3(512), args, LDS_BYTES, stream);
    if (e != hipSuccess) fprintf(stderr, "cooperative launch failed: %s (grid %d)\n", hipGetErrorString(e), grid);
}
```

```cpp
#include <hip/hip_runtime.h>
#include <hip/hip_cooperative_groups.h>
#include <cstdio>
#include <cstdint>
namespace cg = cooperative_groups;
#define GAS __attribute__((address_space(1)))
#define LAS __attribute__((address_space(3)))
typedef unsigned short bf16;
typedef unsigned v4u __attribute__((ext_vector_type(4)));
typedef unsigned v2u __attribute__((ext_vector_type(2)));
typedef float f32x4 __attribute__((ext_vector_type(4)));
typedef float f32x2 __attribute__((ext_vector_type(2)));
constexpr int DM = 1024, NB = 8, SEQ = 4096, NCTX = 256, ML = NB * SEQ, MC = NB * NCTX, MT = ML + MC;
constexpr int S5W = 512, CVW = 512, INC = 1536, DFF = 4096, NG = 32, NP = 64, NH = 16, CK = 31;
constexpr float EPS_RMS = 1e-6f, EPS_LN = 1e-5f;
constexpr size_t MiB = 1u << 20;
constexpr size_t WS_HID = 0;
constexpr size_t WS_A1 = 0, WS_S = 0;
constexpr size_t WS_X = 68 * MiB;
constexpr size_t WS_XC = 132 * MiB;
constexpr size_t WS_HC = 134 * MiB, WS_G = 134 * MiB;
constexpr size_t WS_YC = 166 * MiB;
constexpr size_t WS_H1 = 256 * MiB;
constexpr size_t WS_HS = 384 * MiB;
constexpr size_t WS_WIN = 448 * MiB, WS_WGLU = 451 * MiB, WS_WOUT = 452 * MiB, WS_W1 = 454 * MiB, WS_W2 = 462 * MiB;
constexpr size_t WS_MOD = 470 * MiB, WS_MODC = WS_MOD + 256 * 1024, WS_BIAS1 = WS_MOD + 512 * 1024;
constexpr size_t WS_BAR = WS_MOD + 768 * 1024;
constexpr size_t WS_SS1 = 471 * MiB;
constexpr size_t WS_APOW = 473 * MiB;
constexpr size_t WS_BB = 474 * MiB;
constexpr size_t WS_KT = 475 * MiB;
constexpr size_t WS_WT = 476 * MiB;
constexpr size_t WS_MET = 480 * MiB;
constexpr size_t WS_END = 512 * MiB;
constexpr int LDS_BYTES = 139264;
constexpr int LDS_MISC = 131072 + 256;

struct Params {
    const float *x, *c, *ctx, *c_ctx, *ada_w, *ada_b, *norm1_g, *w_in, *lam_re, *lam_im, *log_dt, *b_re, *b_im, *c_re, *c_im, *s5_d, *w_glu,
                *conv_w, *conv_b, *ln_g, *ln_b, *w_out, *norm2_g, *w1, *w2, *final_g;
    float* out; unsigned char* ws;
};

__device__ __forceinline__ unsigned f2bf(float f) { unsigned u = __builtin_bit_cast(unsigned, f); return (u + 0x7fffu + ((u >> 16) & 1u)) >> 16; }
__device__ __forceinline__ unsigned pk2(float lo, float hi) { return f2bf(lo) | (f2bf(hi) << 16); }
__device__ __forceinline__ float bflo(unsigned w) { return __builtin_bit_cast(float, w << 16); }
__device__ __forceinline__ float bfhi(unsigned w) { return __builtin_bit_cast(float, w & 0xffff0000u); }
__device__ __forceinline__ float wave_sum(float v) {
#pragma unroll
    for (int o = 1; o < 64; o <<= 1) v += __shfl_xor(v, o);
    return v;
}
__device__ __forceinline__ float sigmoidf_(float g) { return __builtin_amdgcn_rcpf(1.0f + __expf(-g)); }
__device__ __forceinline__ float gelu_tanh(float y) {
    const float z = 0.7978845608028654f * (y + 0.044715f * y * y * y);
    const float th = 1.0f - 2.0f * __builtin_amdgcn_rcpf(1.0f + __expf(2.0f * z));
    return 0.5f * y * (1.0f + th);
}
#define LDS_WAIT() asm volatile("s_waitcnt lgkmcnt(0)" ::: "memory")

#define XB_TMO      128
#define XB_XCNT(j)  (256  + 64 * (j))
#define XB_XSUB(j)  (1280 + 64 * (j))
#define XB_XGEN(j)  (2304 + 64 * (j))
#define XB_TOP      3328
#define XB_TOPGEN   3392
#define XCD_BAR_WORDS 3456
#define XB_SPIN_CAP (1u << 18)

__device__ __forceinline__ unsigned xb_ld(unsigned* p)              { return __hip_atomic_load(p, __ATOMIC_RELAXED, __HIP_MEMORY_SCOPE_AGENT); }
__device__ __forceinline__ unsigned xb_add(unsigned* p, unsigned v) { return __hip_atomic_fetch_add(p, v, __ATOMIC_RELAXED, __HIP_MEMORY_SCOPE_AGENT); }
__device__ __forceinline__ unsigned xb_xcc_id() { return (unsigned)__builtin_amdgcn_s_getreg((3 << 11) | 20) & 0xFu; }
#define XB_SPIN(cond, bar) do { unsigned _sp = 0; while (cond) { __builtin_amdgcn_s_sleep(1); \
    if ((++_sp & 255u) == 0u) { if (xb_ld(&(bar)[XB_TMO])) break; if (_sp > XB_SPIN_CAP) { atomicAdd(&(bar)[XB_TMO], 1u); break; } } } } while (0)

struct XcdBarrier {
    unsigned* bar; unsigned x;
    volatile LAS unsigned* st;
};

__device__ __forceinline__ XcdBarrier xcd_barrier_post(unsigned* bar, volatile LAS unsigned* st) {
    XcdBarrier b; b.bar = bar; b.x = xb_xcc_id(); b.st = st;
    if (threadIdx.x == 0) (void)xb_add(&bar[XB_XCNT(b.x)], 1u);
    return b;
}
__device__ __forceinline__ void xcd_barrier_complete(unsigned* bar, unsigned x, unsigned& nloc, unsigned& nx) {
    const unsigned G = gridDim.x * gridDim.y * gridDim.z;
    unsigned sum, cnt, mine, sp = 0u;
    for (;;) {
        sum = 0u; cnt = 0u; mine = 0u;
#pragma unroll
        for (unsigned j = 0; j < 16; ++j) { const unsigned c = xb_ld(&bar[XB_XCNT(j)]); sum += c; cnt += (c > 0u) ? 1u : 0u; mine = (j == x) ? c : mine; }
        if (sum == G) break;
        __builtin_amdgcn_s_sleep(1);
        if ((++sp & 255u) == 0u) { if (xb_ld(&bar[XB_TMO])) break; if (sp > XB_SPIN_CAP) { atomicAdd(&bar[XB_TMO], 1u); break; } }
    }
    nloc = mine > 0u ? mine : 1u; nx = cnt > 0u ? cnt : 1u;
}

__device__ __forceinline__ void xcd_barrier(const XcdBarrier& b) {
    asm volatile("s_waitcnt vmcnt(0)" ::: "memory");
    __syncthreads();
    if (threadIdx.x == 0) {
        unsigned* bar = b.bar;
        __builtin_amdgcn_s_waitcnt(0);
        unsigned nloc = b.st[0], nx = b.st[1];
        if (nloc == 0u) { xcd_barrier_complete(bar, b.x, nloc, nx); b.st[0] = nloc; b.st[1] = nx; }
        const unsigned old = xb_add(&bar[XB_XSUB(b.x)], 1u);
        const unsigned gen = old / nloc;
        if (old + 1u == (gen + 1u) * nloc) {
            __builtin_amdgcn_fence(__ATOMIC_RELEASE, "agent");
            asm volatile("s_waitcnt vmcnt(0)" ::: "memory");
            const unsigned og = xb_add(&bar[XB_TOP], 1u);
            const unsigned tg = og / nx;
            if (og + 1u == (tg + 1u) * nx) xb_add(&bar[XB_TOPGEN], 1u);
            else XB_SPIN(xb_ld(&bar[XB_TOPGEN]) == tg, bar);
            __builtin_amdgcn_fence(__ATOMIC_ACQUIRE, "agent");
            xb_add(&bar[XB_XGEN(b.x)], 1u);
            asm volatile("s_waitcnt vmcnt(0)" ::: "memory");
        } else {
            XB_SPIN(xb_ld(&bar[XB_XGEN(b.x)]) == gen, bar);
            __builtin_amdgcn_fence(__ATOMIC_ACQUIRE, "agent");
            asm volatile("s_waitcnt vmcnt(0)" ::: "memory");
        }
    }
    __syncthreads();
}
namespace pg8 {
#define PG8_LAS __attribute__((address_space(3)))
typedef unsigned short bf16_t;
typedef short bf16x8 __attribute__((ext_vector_type(8)));
typedef float f32x4 __attribute__((ext_vector_type(4)));
typedef unsigned u32x4 __attribute__((ext_vector_type(4)));
constexpr int BM = 256, BK = 64, HALF = 128, HTB = HALF * BK * 2  , STAGE_BYTES = 8 * HTB, NXCD = 8, WGM = 8;

__host__ __device__ __forceinline__ int lds_byte(int r, int c) { const int st = (r >> 4) * 2 + (c >> 5), rr = r & 15, cc = c & 31, ob = rr * 64 + cc * 2; return st * 1024 + (ob ^ (((ob >> 9) & 1) << 5)); }
__host__ __device__ __forceinline__ void stage_rc(int b, int& R, int& C) { const int st = b / 1024, sb = b % 1024, swz = sb ^ (((sb >> 9) & 1) << 5); R = (st >> 1) * 16 + swz / 64; C = (st & 1) * 32 + (swz % 64) / 2; }
__host__ __device__ __forceinline__ int perm32(int rho) { const int n = rho >> 4, i = rho & 15; return 8 * (i >> 2) + 4 * n + (i & 3); }

struct Unit { int pm, pn; };
struct Gemm { const bf16_t* A; const bf16_t* Bt; int M, N, K, lda; };

struct StaticOrder {
    int nM, nN, nwg, G, c;
    __host__ __device__ void init(int M, int N, int G_, int c_) { nM = M / BM; nN = N / BM; nwg = nM * nN; G = G_; c = c_; }
    __host__ __device__ bool next(int i, Unit& u) const {
        const long L = (long)i * G + c; if (L >= nwg) return false;
        int wgid = (int)L; { const int q = nwg / NXCD, r = nwg % NXCD, xcd = wgid % NXCD, off = wgid / NXCD; wgid = (xcd < r ? xcd * (q + 1) : r * (q + 1) + (xcd - r) * q) + off; }
        const int nig = WGM * nN, gid = wgid / nig, fm = gid * WGM, gsz = (nM - fm) < WGM ? (nM - fm) : WGM;
        u.pm = fm + ((wgid % nig) % gsz); u.pn = (wgid % nig) / gsz; return true;
    }
    __device__ __forceinline__ void a_ready(const Unit&) const {}
    __device__ __forceinline__ void done(const Unit&) const {}
};

__device__ __forceinline__ unsigned cvt_pk_bf16(float lo, float hi) { unsigned r; asm volatile("v_cvt_pk_bf16_f32 %0, %1, %2" : "=v"(r) : "v"(lo), "v"(hi)); return r; }
typedef float f32x2 __attribute__((ext_vector_type(2)));
}
namespace pg8 {
typedef unsigned u32x4 __attribute__((ext_vector_type(4)));
typedef unsigned u32x2 __attribute__((ext_vector_type(2)));
struct EpiG1 {
    static constexpr bool PERM = true, AFTER_DRAIN = false;
    bf16_t* X; bf16_t* XC; bf16_t* HC;
    __device__ __forceinline__ void operator()(const f32x4 (&acc)[2][2][4][2], const Unit& u, int wr, int wc, int fr, int fq) const {
        const int row0 = u.pm * BM + wr * 64 + fr;
        if (u.pn < 2) {
            const int col0 = u.pn * BM + wc * 32 + 8 * fq;
#pragma unroll
            for (int ai = 0; ai < 2; ++ai)
#pragma unroll
                for (int m = 0; m < 4; ++m) { const int row = row0 + ai * HALF + m * 16;
#pragma unroll
                    for (int bj = 0; bj < 2; ++bj) { const int col = col0 + bj * HALF, g = col >> 4, j0 = col & 15; bf16_t* dst;
                        if (row < ML) { const int b = row >> 12, c = (row >> 4) & 255, s = row & 15; dst = X + ((size_t)((b * 32 + g) * 256 + c)) * 512 + s * 16 + j0; }
                        else { const int rr = row - ML, b = rr >> 8, c = (rr >> 4) & 15, s = rr & 15; dst = XC + ((size_t)((b * 32 + g) * 16 + c)) * 256 + s * 16 + j0; }
                        const f32x4 v0 = acc[ai][bj][m][0], v1 = acc[ai][bj][m][1]; u32x4 w;
                        w.x = cvt_pk_bf16(v0[0], v0[1]); w.y = cvt_pk_bf16(v0[2], v0[3]); w.z = cvt_pk_bf16(v1[0], v1[1]); w.w = cvt_pk_bf16(v1[2], v1[3]);
                        *(u32x4*)dst = w; } }
        } else {
            const int ch0 = (u.pn - 2) * HALF + wc * 32 + 8 * fq;
#pragma unroll
            for (int ai = 0; ai < 2; ++ai)
#pragma unroll
                for (int m = 0; m < 4; ++m) { bf16_t* rowp = HC + (size_t)(row0 + ai * HALF + m * 16) * 512 + ch0; float h[8];
#pragma unroll
                    for (int n = 0; n < 2; ++n)
#pragma unroll
                        for (int j = 0; j < 4; ++j) h[n * 4 + j] = acc[ai][0][m][n][j] * sigmoidf_(acc[ai][1][m][n][j]);
                    u32x4 w; w.x = cvt_pk_bf16(h[0], h[1]); w.y = cvt_pk_bf16(h[2], h[3]); w.z = cvt_pk_bf16(h[4], h[5]); w.w = cvt_pk_bf16(h[6], h[7]);
                    *(u32x4*)rowp = w; }
        }
    }
};
struct EpiS5A {
    static constexpr bool PERM = false, AFTER_DRAIN = false;
    float* S;
    __device__ __forceinline__ void operator()(const f32x4 (&acc)[2][2][4][2], const Unit& u, int wr, int wc, int fr, int fq) const {
        float* rp = S + ((size_t)u.pm * 256 + wr * 64 + fr) * 256 + wc * 32 + 4 * fq;
#pragma unroll
        for (int ai = 0; ai < 2; ++ai) {
#pragma unroll
            for (int m = 0; m < 4; ++m) {
#pragma unroll
                for (int bj = 0; bj < 2; ++bj)
#pragma unroll
                    for (int n = 0; n < 2; ++n) *(f32x4*)(rp + bj * HALF + n * 16) = acc[ai][bj][m][n];
                rp += 16 * 256; asm volatile("" : "+v"(rp)); }
            rp += 64 * 256; }
    }
};
struct EpiS5C {
    static constexpr bool PERM = true, AFTER_DRAIN = false;
    bf16_t* G;
    __device__ __forceinline__ void operator()(const f32x4 (&acc)[2][2][4][2], const Unit& u, int wr, int wc, int fr, int fq) const {
        const int b = u.pm >> 5, g = u.pm & 31;
#pragma unroll
        for (int ai = 0; ai < 2; ++ai)
#pragma unroll
            for (int m = 0; m < 4; ++m) { const int c = ai * HALF + wr * 64 + m * 16 + fr;
#pragma unroll
                for (int bj = 0; bj < 2; ++bj) { const int o0 = bj * HALF + wc * 32 + 8 * fq, tl = o0 >> 4, i0 = o0 & 15;
                    const f32x4 v0 = acc[ai][bj][m][0], v1 = acc[ai][bj][m][1]; u32x4 w;
                    w.x = cvt_pk_bf16(gelu_tanh(v0[0]), gelu_tanh(v0[1])); w.y = cvt_pk_bf16(gelu_tanh(v0[2]), gelu_tanh(v0[3]));
                    w.z = cvt_pk_bf16(gelu_tanh(v1[0]), gelu_tanh(v1[1])); w.w = cvt_pk_bf16(gelu_tanh(v1[2]), gelu_tanh(v1[3]));
                    *(u32x4*)(G + ((size_t)(b * SEQ + c * 16 + tl)) * 512 + g * 16 + i0) = w; } }
    }
};
struct EpiGlu {
    static constexpr bool PERM = true, AFTER_DRAIN = false;
    const bf16_t* G; bf16_t* YC;
    __device__ __forceinline__ void operator()(const f32x4 (&acc)[2][2][4][2], const Unit& u, int wr, int wc, int fr, int fq) const {
        const int row0 = u.pm * BM + wr * 64 + fr, col0 = u.pn * BM + wc * 32 + 8 * fq;
#pragma unroll
        for (int ai = 0; ai < 2; ++ai)
#pragma unroll
            for (int m = 0; m < 4; ++m) { const size_t row = (size_t)(row0 + ai * HALF + m * 16);
#pragma unroll
                for (int bj = 0; bj < 2; ++bj) { const u32x4 gv = *(const u32x4*)(G + row * 512 + col0 + bj * HALF);
                    const f32x4 v0 = acc[ai][bj][m][0], v1 = acc[ai][bj][m][1]; u32x4 w;
                    w.x = cvt_pk_bf16(bflo(gv.x) * sigmoidf_(v0[0]), bfhi(gv.x) * sigmoidf_(v0[1]));
                    w.y = cvt_pk_bf16(bflo(gv.y) * sigmoidf_(v0[2]), bfhi(gv.y) * sigmoidf_(v0[3]));
                    w.z = cvt_pk_bf16(bflo(gv.z) * sigmoidf_(v1[0]), bfhi(gv.z) * sigmoidf_(v1[1]));
                    w.w = cvt_pk_bf16(bflo(gv.w) * sigmoidf_(v1[2]), bfhi(gv.w) * sigmoidf_(v1[3]));
                    *(u32x4*)(YC + row * 1024 + col0 + bj * HALF) = w; } }
    }
};
struct EpiOut {
    static constexpr bool PERM = false, AFTER_DRAIN = false;
    const float* x; const float* mod; const float* n2g; float* H1; bf16_t* HS; float* SS1;
    __device__ __forceinline__ void operator()(const f32x4 (&acc)[2][2][4][2], const Unit& u, int wr, int wc, int fr, int fq) const {
        const int row0 = u.pm * BM + wr * 64 + fr, col0 = u.pn * BM + wc * 32 + 4 * fq;
        const int b = (u.pm * BM) >> 12;
        const float* mb = mod + (size_t)b * 6144;
        f32x4 g1v[2][2], wsv[2][2];
#pragma unroll
        for (int bj = 0; bj < 2; ++bj)
#pragma unroll
            for (int n = 0; n < 2; ++n) { const int c = col0 + bj * HALF + n * 16;
                g1v[bj][n] = *(const f32x4*)(mb + 2048 + c);
                wsv[bj][n] = *(const f32x4*)(n2g + c) * (*(const f32x4*)(mb + 4096 + c) + 1.0f); }
#pragma unroll
        for (int ai = 0; ai < 2; ++ai)
#pragma unroll
            for (int m = 0; m < 4; ++m) { const int row = row0 + ai * HALF + m * 16; const size_t off = (size_t)row * DM + col0; float ss = 0.f;
#pragma unroll
                for (int bj = 0; bj < 2; ++bj)
#pragma unroll
                    for (int n = 0; n < 2; ++n) { const size_t o = off + bj * HALF + n * 16;
                        const f32x4 h1 = *(const f32x4*)(x + o) + g1v[bj][n] * acc[ai][bj][m][n];
                        *(f32x4*)(H1 + o) = h1; ss += (h1[0] * h1[0] + h1[1] * h1[1]) + (h1[2] * h1[2] + h1[3] * h1[3]);
                        const f32x4 hs = h1 * wsv[bj][n]; u32x2 w; w.x = cvt_pk_bf16(hs[0], hs[1]); w.y = cvt_pk_bf16(hs[2], hs[3]);
                        *(u32x2*)(HS + o) = w; }
                ss += __shfl_xor(ss, 16); ss += __shfl_xor(ss, 32);
                if (fq == 0) SS1[(size_t)row * 16 + u.pn * 4 + wc] = ss; }
    }
};
struct EpiUp {
    static constexpr bool PERM = true, AFTER_DRAIN = false;
    const float* SS1; const float* bias1; bf16_t* HID;
    __device__ __forceinline__ void operator()(const f32x4 (&acc)[2][2][4][2], const Unit& u, int wr, int wc, int fr, int fq) const {
        const int row0 = u.pm * BM + wr * 64 + fr, col0 = u.pn * BM + wc * 32 + 8 * fq;
        const int b = (u.pm * BM) >> 12;
        f32x4 bv[2][2];
#pragma unroll
        for (int bj = 0; bj < 2; ++bj)
#pragma unroll
            for (int n = 0; n < 2; ++n) bv[bj][n] = *(const f32x4*)(bias1 + (size_t)b * DFF + col0 + bj * HALF + 4 * n);
#pragma unroll
        for (int ai = 0; ai < 2; ++ai)
#pragma unroll
            for (int m = 0; m < 4; ++m) { const int row = row0 + ai * HALF + m * 16;
                const f32x4* sp = (const f32x4*)(SS1 + (size_t)row * 16); const f32x4 s0 = sp[0], s1 = sp[1], s2 = sp[2], s3 = sp[3];
                const float ss = ((s0[0] + s0[1]) + (s0[2] + s0[3])) + ((s1[0] + s1[1]) + (s1[2] + s1[3])) + ((s2[0] + s2[1]) + (s2[2] + s2[3])) + ((s3[0] + s3[1]) + (s3[2] + s3[3]));
                const float rstd = rsqrtf(ss * (1.0f / DM) + EPS_RMS);
                bf16_t* rowp = HID + (size_t)row * DFF + col0;
#pragma unroll
                for (int bj = 0; bj < 2; ++bj) { f32x4 v0 = acc[ai][bj][m][0] * rstd + bv[bj][0], v1 = acc[ai][bj][m][1] * rstd + bv[bj][1];
#pragma unroll
                    for (int j = 0; j < 4; ++j) { const float a = fmaxf(v0[j], 0.f), c = fmaxf(v1[j], 0.f); v0[j] = a * a; v1[j] = c * c; }
                    u32x4 w; w.x = cvt_pk_bf16(v0[0], v0[1]); w.y = cvt_pk_bf16(v0[2], v0[3]); w.z = cvt_pk_bf16(v1[0], v1[1]); w.w = cvt_pk_bf16(v1[2], v1[3]);
                    *(u32x4*)(rowp + bj * HALF) = w; } }
    }
};
struct EpiDown {
    static constexpr bool PERM = false, AFTER_DRAIN = false;
    const float* H1; const float* mod; float* out;
    __device__ __forceinline__ void operator()(const f32x4 (&acc)[2][2][4][2], const Unit& u, int wr, int wc, int fr, int fq) const {
        const int row0 = u.pm * BM + wr * 64 + fr, col0 = u.pn * BM + wc * 32 + 4 * fq;
        const int b = (u.pm * BM) >> 12;
        const float* mb = mod + (size_t)b * 6144 + 5120;
        f32x4 g2v[2][2];
#pragma unroll
        for (int bj = 0; bj < 2; ++bj)
#pragma unroll
            for (int n = 0; n < 2; ++n) g2v[bj][n] = *(const f32x4*)(mb + col0 + bj * HALF + n * 16);
#pragma unroll
        for (int ai = 0; ai < 2; ++ai)
#pragma unroll
            for (int m = 0; m < 4; ++m) { const size_t off = (size_t)(row0 + ai * HALF + m * 16) * DM + col0;
#pragma unroll
                for (int bj = 0; bj < 2; ++bj)
#pragma unroll
                    for (int n = 0; n < 2; ++n) { const size_t o = off + bj * HALF + n * 16;
                        *(f32x4*)(out + o) = *(const f32x4*)(H1 + o) + g2v[bj][n] * acc[ai][bj][m][n]; } }
    }
};
struct G1Order {
    StaticOrder so;
    __device__ void init(int G, int c) { so.init(ML, INC, G, c); }
    __device__ bool next(int i, Unit& u) const {
        const long L = (long)i * so.G + so.c;
        if (L < so.nwg) return so.next(i, u);
        const int e = (int)(L - so.nwg); if (e >= 16) return false;
        u.pm = 128 + (e >> 1); u.pn = e & 1; return true;
    }
    __device__ __forceinline__ void a_ready(const Unit&) const {}
    __device__ __forceinline__ void done(const Unit&) const {}
};
struct ItemOrder {
    int G, c, n;
    __device__ bool next(int i, Unit& u) const { const int it = c + i * G; if (it >= n) return false; u.pm = it; u.pn = it & 31; return true; }
    __device__ __forceinline__ void a_ready(const Unit&) const {}
    __device__ __forceinline__ void done(const Unit&) const {}
};
struct OneUnit {
    int pm, pn;
    __device__ bool next(int i, Unit& u) const { if (i) return false; u.pm = pm; u.pn = pn; return true; }
    __device__ __forceinline__ void a_ready(const Unit&) const {}
    __device__ __forceinline__ void done(const Unit&) const {}
};
}
namespace pg8 {
template <class Epi, class Sched, bool ALIGN_EPI = false, bool SP2 = false>
__device__ __forceinline__ void gemm_phase(PG8_LAS unsigned char* lds, const Gemm g, const Sched& S, const Epi& E, int tid_in) {
    int tid_l = tid_in; asm volatile("" : "+v"(tid_l));
    const int tid = tid_l, wid = __builtin_amdgcn_readfirstlane(tid >> 6), lane = tid & 63, wr = wid >> 2, wc = wid & 3, fr = lane & 15, fq = lane >> 4;
    const int K = g.K; int nt_l = K / BK; asm volatile("" : "+s"(nt_l)); const int nt = nt_l;
    unsigned voffA[2], voffB[2];
#pragma unroll
    for (int i = 0; i < 2; ++i) { int R, C; stage_rc(tid * 16 + i * 8192, R, C); const int Rb = Epi::PERM ? ((R & ~31) + perm32(R & 31)) : R;
        voffA[i] = (unsigned)(R * g.lda + C) * 2u; voffB[i] = (unsigned)(Rb * K + C) * 2u; }
    const size_t kstep = (size_t)(BK * 2);
    const size_t hstep = (size_t)HALF * K * 2; const size_t hstepA = (size_t)HALF * g.lda * 2; const size_t tstepA = 2 * hstepA;
    const size_t tstep = 2 * hstep;
    const unsigned ldsw = (unsigned)wid * 1024u;
    const int aoff = lds_byte(wr * 64 + fr, fq * 8), boff = lds_byte(wc * 32 + fr, fq * 8);
#define PG8_SA(b, h) (((b) * 2 + (h)) * HTB)
#define PG8_SB(b, h) ((4 + (b) * 2 + (h)) * HTB)
#define PG8_STAGE(bufoff, gbase, voff) do { _Pragma("unroll") for (int _i = 0; _i < 2; ++_i) \
        __builtin_amdgcn_global_load_lds((const unsigned*)((const char*)(gbase) + (voff)[_i]), (PG8_LAS unsigned*)(lds + (bufoff) + ldsw + _i * 8192), 16, 0, 0); } while (0)
#define PG8_LDA(dst, b, h) do { _Pragma("unroll") for (int m = 0; m < 4; ++m) _Pragma("unroll") for (int k = 0; k < 2; ++k) dst[m][k] = *(const PG8_LAS bf16x8*)(lds + PG8_SA(b, h) + aoff + m * 2048 + k * 1024); } while (0)
#define PG8_LDB(dst, b, h) do { _Pragma("unroll") for (int n = 0; n < 2; ++n) _Pragma("unroll") for (int k = 0; k < 2; ++k) dst[n][k] = *(const PG8_LAS bf16x8*)(lds + PG8_SB(b, h) + boff + n * 2048 + k * 1024); } while (0)
#define PG8_MMA(ai, bj, At, Bt) do { __builtin_amdgcn_s_setprio(1); _Pragma("unroll") for (int m = 0; m < 4; ++m) _Pragma("unroll") for (int n = 0; n < 2; ++n) _Pragma("unroll") for (int k = 0; k < 2; ++k) \
        acc[ai][bj][m][n] = __builtin_amdgcn_mfma_f32_16x16x32_bf16(Bt[n][k], At[m][k], acc[ai][bj][m][n], 0, 0, 0); __builtin_amdgcn_s_setprio(0); } while (0)
#define PG8_WAIT_V(n) asm volatile("s_waitcnt vmcnt(" #n ")" ::: "memory")
#define PG8_WAIT_L(n) asm volatile("s_waitcnt lgkmcnt(" #n ")" ::: "memory")
#define PG8_BAR __builtin_amdgcn_s_barrier()
#define PG8_SCHED __builtin_amdgcn_sched_barrier(0)
    Unit cur, nxt; int ui = 0;
    if (!S.next(0, cur)) return;
    f32x4 acc[2][2][4][2];
#pragma unroll
    for (int a = 0; a < 2; ++a)
#pragma unroll
        for (int b = 0; b < 2; ++b)
#pragma unroll
            for (int m = 0; m < 4; ++m)
#pragma unroll
                for (int n = 0; n < 2; ++n) acc[a][b][m][n] = (f32x4){0.f, 0.f, 0.f, 0.f};
    bf16x8 At[4][2], B0[2][2], B1[2][2];
    const char* cA = (const char*)g.A + (size_t)cur.pm * tstepA; const char* cB = (const char*)g.Bt + (size_t)cur.pn * tstep;
    S.a_ready(cur);
    if constexpr (SP2) {
        PG8_STAGE(PG8_SB(0, 0), cB, voffB); PG8_STAGE(PG8_SB(0, 1), cB + hstep, voffB); PG8_STAGE(PG8_SA(0, 0), cA, voffA); PG8_STAGE(PG8_SA(0, 1), cA + hstepA, voffA);
        if (wr == 1) PG8_BAR;
        PG8_WAIT_V(2); PG8_BAR;
        PG8_STAGE(PG8_SB(1, 0), cB + kstep, voffB); PG8_STAGE(PG8_SA(1, 0), cA + kstep, voffA); PG8_STAGE(PG8_SB(1, 1), cB + hstep + kstep, voffB);
        PG8_WAIT_V(6); PG8_BAR;
    } else {
        PG8_STAGE(PG8_SB(0, 0), cB, voffB); PG8_STAGE(PG8_SA(0, 0), cA, voffA); PG8_STAGE(PG8_SB(0, 1), cB + hstep, voffB); PG8_STAGE(PG8_SA(0, 1), cA + hstepA, voffA);
        if (wr == 1) PG8_BAR;
        PG8_WAIT_V(4); PG8_BAR;
        PG8_STAGE(PG8_SB(1, 0), cB + kstep, voffB); PG8_STAGE(PG8_SA(1, 0), cA + kstep, voffA); PG8_STAGE(PG8_SB(1, 1), cB + hstep + kstep, voffB);
        PG8_WAIT_V(6); PG8_BAR;
    }
    for (;;) {
        const bool has_next = S.next(ui + 1, nxt);
        const char* nA = has_next ? (const char*)g.A + (size_t)nxt.pm * tstepA : cA; const char* nB = has_next ? (const char*)g.Bt + (size_t)nxt.pn * tstep : cB;
        for (int t = 0; t < nt; t += 2) {
            const bool last = (t == nt - 2);
            const char* a1 = cA + (size_t)(t + 1) * kstep;
            const char* a2 = last ? nA : cA + (size_t)(t + 2) * kstep; const char* b2 = last ? nB : cB + (size_t)(t + 2) * kstep;
            const char* a3 = a2 + kstep; const char* b3 = b2 + kstep;
            if (last && has_next) S.a_ready(nxt);
            if constexpr (SP2) {
            PG8_LDB(B0, 0, 0); PG8_LDB(B1, 0, 1); PG8_SCHED; PG8_LDA(At, 0, 0); PG8_STAGE(PG8_SA(1, 1), a1 + hstepA, voffA);
            PG8_WAIT_V(8); PG8_WAIT_L(0); PG8_BAR; PG8_MMA(0, 0, At, B0); PG8_MMA(0, 1, At, B1); PG8_BAR; PG8_SCHED;
            PG8_LDA(At, 0, 1); PG8_STAGE(PG8_SB(0, 0), b2, voffB); PG8_STAGE(PG8_SB(0, 1), b2 + hstep, voffB); PG8_STAGE(PG8_SA(0, 0), a2, voffA);
            PG8_WAIT_V(8); PG8_WAIT_L(0); PG8_BAR; PG8_MMA(1, 0, At, B0); PG8_MMA(1, 1, At, B1); PG8_BAR; PG8_SCHED;
            PG8_LDB(B0, 1, 0); PG8_LDB(B1, 1, 1); PG8_SCHED; PG8_LDA(At, 1, 0); PG8_STAGE(PG8_SA(0, 1), a2 + hstepA, voffA);
            PG8_WAIT_V(8); PG8_WAIT_L(0); PG8_BAR; PG8_MMA(0, 0, At, B0); PG8_MMA(0, 1, At, B1); PG8_BAR; PG8_SCHED;
            PG8_LDA(At, 1, 1); PG8_STAGE(PG8_SB(1, 0), b3, voffB); PG8_STAGE(PG8_SB(1, 1), b3 + hstep, voffB); PG8_STAGE(PG8_SA(1, 0), a3, voffA);
            PG8_WAIT_V(8); PG8_WAIT_L(0); PG8_BAR; PG8_MMA(1, 0, At, B0); PG8_MMA(1, 1, At, B1); PG8_BAR; PG8_SCHED;
            } else {
            PG8_LDB(B0, 0, 0); PG8_SCHED; PG8_LDA(At, 0, 0); PG8_STAGE(PG8_SA(1, 1), a1 + hstepA, voffA);
            PG8_WAIT_L(8); PG8_BAR; PG8_WAIT_L(0); PG8_MMA(0, 0, At, B0); PG8_BAR; PG8_SCHED;
            PG8_LDB(B1, 0, 1); PG8_STAGE(PG8_SB(0, 0), b2, voffB);
            PG8_BAR; PG8_WAIT_L(0); PG8_MMA(0, 1, At, B1); PG8_BAR;
            PG8_LDA(At, 0, 1); PG8_STAGE(PG8_SA(0, 0), a2, voffA);
            PG8_BAR; PG8_WAIT_L(0); PG8_MMA(1, 0, At, B0); PG8_BAR; PG8_SCHED;
            PG8_STAGE(PG8_SB(0, 1), b2 + hstep, voffB);
            PG8_WAIT_V(6); PG8_BAR; PG8_MMA(1, 1, At, B1); PG8_BAR;
            PG8_LDB(B0, 1, 0); PG8_SCHED; PG8_LDA(At, 1, 0); PG8_STAGE(PG8_SA(0, 1), a2 + hstepA, voffA);
            PG8_WAIT_L(8); PG8_BAR; PG8_WAIT_L(0); PG8_MMA(0, 0, At, B0); PG8_BAR; PG8_SCHED;
            PG8_LDB(B1, 1, 1); PG8_STAGE(PG8_SB(1, 0), b3, voffB);
            PG8_BAR; PG8_WAIT_L(0); PG8_MMA(0, 1, At, B1); PG8_BAR;
            PG8_LDA(At, 1, 1); PG8_STAGE(PG8_SA(1, 0), a3, voffA);
            PG8_BAR; PG8_WAIT_L(0); PG8_MMA(1, 0, At, B0); PG8_BAR; PG8_SCHED;
            PG8_STAGE(PG8_SB(1, 1), b3 + hstep, voffB);
            PG8_WAIT_V(6); PG8_BAR; PG8_MMA(1, 1, At, B1); PG8_BAR;
            }
        }
        if constexpr (ALIGN_EPI) { if (wr == 0) PG8_BAR; }
        if constexpr (!Epi::AFTER_DRAIN) { int fr_e = fr, fq_e = fq; asm volatile("" : "+v"(fr_e), "+v"(fq_e));   E(acc, cur, wr, wc, fr_e, fq_e); S.done(cur); }
        if (!has_next) break;
#pragma unroll
        for (int a = 0; a < 2; ++a)
#pragma unroll
            for (int b = 0; b < 2; ++b)
#pragma unroll
                for (int m = 0; m < 4; ++m)
#pragma unroll
                    for (int n = 0; n < 2; ++n) acc[a][b][m][n] = (f32x4){0.f, 0.f, 0.f, 0.f};
        cur = nxt; cA = nA; cB = nB; ++ui;
        if constexpr (ALIGN_EPI) { if (wr == 1) PG8_BAR; }
    }
    PG8_WAIT_V(0);
    if constexpr (!ALIGN_EPI) { if (wr == 0) PG8_BAR; }
    PG8_BAR;
    if constexpr (Epi::AFTER_DRAIN) { E.fused(acc, cur, wr, wc, fr, fq, lds, wid, lane); S.done(cur); }
#undef PG8_SA
#undef PG8_SB
#undef PG8_STAGE
#undef PG8_LDA
#undef PG8_LDB
#undef PG8_MMA
#undef PG8_WAIT_V
#undef PG8_WAIT_L
#undef PG8_BAR
#undef PG8_SCHED
}
}
__device__ __forceinline__ double dexp_(double x) {
    const double k = __builtin_rint(x * 1.4426950408889634);
    const double r = (x - k * 0.693147180369123816490e+00) - k * 1.90821492927058770002e-10;
    double t = 1.0 / 6227020800.0;
    t = t * r + 1.0 / 479001600.0; t = t * r + 1.0 / 39916800.0; t = t * r + 1.0 / 3628800.0; t = t * r + 1.0 / 362880.0; t = t * r + 1.0 / 40320.0;
    t = t * r + 1.0 / 5040.0; t = t * r + 1.0 / 720.0; t = t * r + 1.0 / 120.0; t = t * r + 1.0 / 24.0; t = t * r + 1.0 / 6.0; t = t * r + 0.5; t = t * r + 1.0; t = t * r + 1.0;
    const long long bits = (long long)(1023 + (int)k) << 52;
    return t * __builtin_bit_cast(double, bits);
}
__device__ __forceinline__ void dsincos_(double th, double& s, double& c) {
    const double k = __builtin_rint(th * 0.63661977236758134308);
    const double r = (th - k * 1.57079632673412561417e+00) - k * 6.07710050650619224932e-11;
    const double r2 = r * r;
    double ps = -1.0 / 1307674368000.0; ps = ps * r2 + 1.0 / 6227020800.0; ps = ps * r2 - 1.0 / 39916800.0; ps = ps * r2 + 1.0 / 362880.0; ps = ps * r2 - 1.0 / 5040.0; ps = ps * r2 + 1.0 / 120.0; ps = ps * r2 - 1.0 / 6.0; ps = ps * r2 + 1.0;
    const double sr = ps * r;
    double pc = 1.0 / 20922789888000.0; pc = pc * r2 - 1.0 / 87178291200.0; pc = pc * r2 + 1.0 / 479001600.0; pc = pc * r2 - 1.0 / 3628800.0; pc = pc * r2 + 1.0 / 40320.0; pc = pc * r2 - 1.0 / 720.0; pc = pc * r2 + 1.0 / 24.0; pc = pc * r2 - 0.5; pc = pc * r2 + 1.0;
    const int q = ((int)k) & 3;
    s = (q == 0) ? sr : (q == 1) ? pc : (q == 2) ? -sr : -pc;
    c = (q == 0) ? pc : (q == 1) ? -sr : (q == 2) ? -pc : sr;
}
__device__ __forceinline__ int win_dest_row(int n) {
    if (n < 512) return n;
    if (n < 1024) { const int c = n - 512; return 512 + (c >> 7) * 256 + (c & 127); }
    const int c = n - 1024; return 512 + (c >> 7) * 256 + 128 + (c & 127);
}
__device__ __forceinline__ void p0_transpose_item(const float* W, int K, int N, bf16* WT, bool perm_win, LAS float* scr, int item, int lane) {
    const int nblk = N / 32, kb = item / nblk, nb = item % nblk, k0 = 64 * kb, n0 = 32 * nb;
    const int r0 = perm_win ? win_dest_row(n0) : n0;
#pragma unroll 8
    for (int i = 0; i < 32; ++i) { const int kk = 2 * i + (lane >> 5); scr[kk * 33 + (lane & 31)] = W[(size_t)(k0 + kk) * N + n0 + (lane & 31)]; }
    LDS_WAIT();
    const int c = lane & 7;
#pragma unroll
    for (int j = 0; j < 4; ++j) { const int n = (lane >> 3) + 8 * j; const LAS float* s = scr + (8 * c) * 33 + n;
        v4u o; o.x = pk2(s[0 * 33], s[1 * 33]); o.y = pk2(s[2 * 33], s[3 * 33]); o.z = pk2(s[4 * 33], s[5 * 33]); o.w = pk2(s[6 * 33], s[7 * 33]);
        *(v4u*)(WT + (size_t)(r0 + n) * K + k0 + 8 * c) = o; }
    LDS_WAIT();
}

__device__ __forceinline__ void phase0(const Params& p, LAS unsigned char* lds, int tid, int lane, int wave, int blk, int G) {
    float* mod = (float*)(p.ws + WS_MOD); float* modc = (float*)(p.ws + WS_MODC);
    LAS float* sl = (LAS float*)lds;
    LAS float* scr = (LAS float*)(lds + 57344 + wave * 9216);
    if (blk < 96) {
        for (int e = tid; e < 9 * 1024; e += 512) { const float v = e < 8192 ? p.c[e] : p.c_ctx[e - 8192]; sl[e] = v / (1.0f + expf(-v)); }
        __syncthreads();
        if (wave == 0) {
            const int n = blk * 64 + lane;
            float acc[9];
#pragma unroll
            for (int j = 0; j < 9; ++j) acc[j] = 0.f;
            for (int k = 0; k < 1024; k += 4) {
                const float w0 = p.ada_w[(size_t)(k + 0) * 6144 + n], w1 = p.ada_w[(size_t)(k + 1) * 6144 + n], w2 = p.ada_w[(size_t)(k + 2) * 6144 + n], w3 = p.ada_w[(size_t)(k + 3) * 6144 + n];
#pragma unroll
                for (int j = 0; j < 9; ++j) { const f32x4 s = *(const LAS f32x4*)(sl + j * 1024 + k); acc[j] += (s[0] * w0 + s[1] * w1) + (s[2] * w2 + s[3] * w3); }
            }
            const float bb = p.ada_b[n];
#pragma unroll
            for (int b = 0; b < 8; ++b) mod[(size_t)b * 6144 + n] = acc[b] + bb;
            if (n < 2048) modc[n] = acc[8] + bb;
        }
    } else if (blk < 128) {
        const int g = blk - 96;
        LAS f32x2* lAp = (LAS f32x2*)lds;
        LAS f32x2* lBb = lAp + 2 * 64 * 17;
        LAS f32x2* lC = lBb + 2 * 64 * 16;
        f32x2* APOW = (f32x2*)(p.ws + WS_APOW); f32x2* BB = (f32x2*)(p.ws + WS_BB); float* KT = (float*)(p.ws + WS_KT);
        if (tid < 128) {
            const int dir = tid >> 6, pp = tid & 63, dg = dir * 32 + g, e = dg * 64 + pp;
            const double lr = (double)p.lam_re[e], li = (double)p.lam_im[e], dt = dexp_((double)p.log_dt[dg]);
            double ar1 = 1.0, ai1 = 0.0;
            for (int n = 0; n <= 16; ++n) { double sn, cs; dsincos_(li * dt * (double)n, sn, cs); const double mag = dexp_(lr * dt * (double)n);
                const f32x2 ap = (f32x2){(float)(mag * cs), (float)(mag * sn)}; lAp[(dir * 64 + pp) * 17 + n] = ap; APOW[(size_t)e * 17 + n] = ap;
                if (n == 1) { ar1 = mag * cs; ai1 = mag * sn; } }
            const double den = lr * lr + li * li, nr = ar1 - 1.0;
            const double fr = (nr * lr + ai1 * li) / den, fi = (ai1 * lr - nr * li) / den;
#pragma unroll 4
            for (int h = 0; h < 16; ++h) { const double br = (double)p.b_re[(size_t)e * 16 + h], bi = (double)p.b_im[(size_t)e * 16 + h];
                const f32x2 bb = (f32x2){(float)(fr * br - fi * bi), (float)(fr * bi + fi * br)}; lBb[(dir * 64 + pp) * 16 + h] = bb; BB[(size_t)e * 16 + h] = bb; }
        }
        for (int e = tid; e < 2 * 16 * 64; e += 512) { const int dir = e >> 10, i = (e >> 6) & 15, pp = e & 63; const size_t idx = (size_t)((dir * 32 + g) * 16 + i) * 64 + pp;
            lC[e] = (f32x2){p.c_re[idx], p.c_im[idx]}; }
        __syncthreads();
        for (int e = tid; e < 2 * 16 * 256; e += 512) { const int dir = e >> 12, tau = (e >> 8) & 15, i = (e >> 4) & 15, j = e & 15; float acc = 0.f;
            for (int pp = 0; pp < 64; ++pp) { const f32x2 C = lC[(dir * 16 + i) * 64 + pp], A = lAp[(dir * 64 + pp) * 17 + tau], B = lBb[(dir * 64 + pp) * 16 + j];
                const float car = C[0] * A[0] - C[1] * A[1], cai = C[0] * A[1] + C[1] * A[0]; acc += car * B[0] - cai * B[1]; }
            KT[(size_t)((dir * 32 + g) * 16 + tau) * 256 + i * 16 + j] = acc; }
    }
    const int gw = blk * 8 + wave, NGW = G * 8;
    constexpr int I_IN = 16 * 48, I_GLU = 8 * 16, I_OUT = 16 * 32, I_1 = 16 * 128, I_2 = 64 * 32, NIT = I_IN + I_GLU + I_OUT + I_1 + I_2;
    for (int it = gw; it < NIT; it += NGW) {
        int r = it;
        if (r < I_IN) { p0_transpose_item(p.w_in, 1024, 1536, (bf16*)(p.ws + WS_WIN), true, scr, r, lane); continue; } r -= I_IN;
        if (r < I_GLU) { p0_transpose_item(p.w_glu, 512, 512, (bf16*)(p.ws + WS_WGLU), false, scr, r, lane); continue; } r -= I_GLU;
        if (r < I_OUT) { p0_transpose_item(p.w_out, 1024, 1024, (bf16*)(p.ws + WS_WOUT), false, scr, r, lane); continue; } r -= I_OUT;
        if (r < I_1) { p0_transpose_item(p.w1, 1024, 4096, (bf16*)(p.ws + WS_W1), false, scr, r, lane); continue; } r -= I_1;
        p0_transpose_item(p.w2, 4096, 1024, (bf16*)(p.ws + WS_W2), false, scr, r, lane);
    }
}

__device__ __forceinline__ void phase1(const Params& p, LAS unsigned char* lds, int tid, int lane, int wave, int blk, int G) {
    const float* mod = (const float*)(p.ws + WS_MOD); const float* modc = (const float*)(p.ws + WS_MODC);
    if (blk < 64) {
        const int n = blk * 64 + lane; float acc[8];
#pragma unroll
        for (int b = 0; b < 8; ++b) acc[b] = 0.f;
        for (int k = wave * 128; k < wave * 128 + 128; ++k) { const float w = p.w1[(size_t)k * DFF + n];
#pragma unroll
            for (int b = 0; b < 8; ++b) acc[b] += mod[(size_t)b * 6144 + 3072 + k] * w; }
        LAS float* red = (LAS float*)lds;
#pragma unroll
        for (int b = 0; b < 8; ++b) red[(wave * 8 + b) * 64 + lane] = acc[b];
        __syncthreads();
        { const int b = tid >> 6; float s = 0.f;
#pragma unroll
          for (int w = 0; w < 8; ++w) s += red[(w * 8 + b) * 64 + lane];
          ((float*)(p.ws + WS_BIAS1))[(size_t)b * DFF + blk * 64 + lane] = s; }
    }
    bf16* A1 = (bf16*)(p.ws + WS_A1);
    const int gw = blk * 8 + wave, NGW = G * 8;
    for (int m = gw; m < MT; m += NGW) {
        const float* xr; const float* sh; const float* sc;
        if (m < ML) { xr = p.x + (size_t)m * DM; sh = mod + (size_t)(m >> 12) * 6144; sc = sh + 1024; }
        else { xr = p.ctx + (size_t)(m - ML) * DM; sh = modc; sc = modc + 1024; }
        f32x4 v[4]; float ss = 0.f;
#pragma unroll
        for (int j = 0; j < 4; ++j) { v[j] = *(const f32x4*)(xr + 4 * lane + 256 * j); ss += (v[j][0] * v[j][0] + v[j][1] * v[j][1]) + (v[j][2] * v[j][2] + v[j][3] * v[j][3]); }
        const float rstd = rsqrtf(wave_sum(ss) * (1.0f / DM) + EPS_RMS);
#pragma unroll
        for (int j = 0; j < 4; ++j) { const int c = 4 * lane + 256 * j;
            const f32x4 g = *(const f32x4*)(p.norm1_g + c), s1 = *(const f32x4*)(sc + c), s0 = *(const f32x4*)(sh + c);
            const f32x4 o = v[j] * rstd * g * (s1 + 1.0f) + s0;
            v2u w; w.x = pk2(o[0], o[1]); w.y = pk2(o[2], o[3]);
            *(v2u*)(A1 + (size_t)m * DM + c) = w; }
    }
}

__device__ __forceinline__ void s5_tables(const Params& p, int tid, int blk, int G) {
    const f32x2* APOW = (const f32x2*)(p.ws + WS_APOW); const f32x2* BB = (const f32x2*)(p.ws + WS_BB); const float* KT = (const float*)(p.ws + WS_KT);
    bf16* WT = (bf16*)(p.ws + WS_WT); bf16* MET = (bf16*)(p.ws + WS_MET);
    for (int it = blk * 512 + tid; it < 262144 + 524288; it += G * 512) {
        float v[8];
        if (it < 262144) {
            const int g = it >> 13, n = (it >> 5) & 255, k0 = (it & 31) * 8, dir = n >> 7, part = (n >> 6) & 1, pp = n & 63, s = k0 >> 4, j0 = k0 & 15;
            const int e = dir ? s : 15 - s; const size_t sp = (size_t)(dir * 32 + g) * 64 + pp;
            const f32x2 A = APOW[sp * 17 + e];
#pragma unroll
            for (int jj = 0; jj < 8; ++jj) { const f32x2 B = BB[sp * 16 + j0 + jj]; v[jj] = part ? (A[0] * B[1] + A[1] * B[0]) : (A[0] * B[0] - A[1] * B[1]); }
            v4u o; o.x = pk2(v[0], v[1]); o.y = pk2(v[2], v[3]); o.z = pk2(v[4], v[5]); o.w = pk2(v[6], v[7]);
            *(v4u*)(WT + ((size_t)(g * 256 + n)) * 256 + k0) = o;
        } else {
            const int it2 = it - 262144, g = it2 >> 14, o_ = (it2 >> 6) & 255, k0 = (it2 & 63) * 8, tl = o_ >> 4, i = o_ & 15;
            if (k0 < 256) {
                const int s = k0 >> 4, j0 = k0 & 15;
#pragma unroll
                for (int jj = 0; jj < 8; ++jj) { const int j = j0 + jj; float a = 0.f;
                    if (s <= tl) a += KT[(size_t)((0 * 32 + g) * 16 + (tl - s)) * 256 + i * 16 + j];
                    if (s >= tl) a += KT[(size_t)((1 * 32 + g) * 16 + (s - tl)) * 256 + i * 16 + j];
                    if (s == tl && i == j) a += p.s5_d[g * 16 + i];
                    v[jj] = a; }
            } else {
                const int kk = k0 - 256, dir = kk >> 7, part = (kk >> 6) & 1, p0 = kk & 63, e = dir ? 16 - tl : tl + 1;
#pragma unroll
                for (int jj = 0; jj < 8; ++jj) { const int pp = p0 + jj; const size_t ci = (size_t)((dir * 32 + g) * 16 + i) * 64 + pp;
                    const float cr = p.c_re[ci], cim = p.c_im[ci]; const f32x2 A = APOW[((size_t)(dir * 32 + g) * 64 + pp) * 17 + e];
                    v[jj] = part ? -(cr * A[1] + cim * A[0]) : (cr * A[0] - cim * A[1]); }
            }
            v4u o; o.x = pk2(v[0], v[1]); o.y = pk2(v[2], v[3]); o.z = pk2(v[4], v[5]); o.w = pk2(v[6], v[7]);
            *(v4u*)(MET + ((size_t)(g * 256 + o_)) * 512 + k0) = o;
        }
    }
}

__device__ __forceinline__ void s5_scan_item(const Params& p, LAS unsigned char* lds, int item, int tid, int lane, int wave) {
    const int g = item & 31;
    const bf16* XC = (const bf16*)(p.ws + WS_XC) + (size_t)item * 16 * 256;
    const bf16* WT = (const bf16*)(p.ws + WS_WT) + (size_t)g * 256 * 256;
    const f32x2* APOW = (const f32x2*)(p.ws + WS_APOW);
    LAS float* Sc = (LAS float*)lds;
    LAS f32x2* Tseg = (LAS f32x2*)(lds + 16384);
    LAS f32x2* H0 = Tseg + 512;
    {
        f32x4 acc0 = (f32x4){0.f, 0.f, 0.f, 0.f}, acc1 = acc0; const int r = lane & 15, kg = lane >> 4;
#pragma unroll
        for (int ks = 0; ks < 8; ++ks) { const pg8::bf16x8 a = *(const pg8::bf16x8*)(XC + r * 256 + ks * 32 + kg * 8);
            const pg8::bf16x8 b0 = *(const pg8::bf16x8*)(WT + (size_t)((2 * wave) * 16 + r) * 256 + ks * 32 + kg * 8), b1 = *(const pg8::bf16x8*)(WT + (size_t)((2 * wave + 1) * 16 + r) * 256 + ks * 32 + kg * 8);
            acc0 = __builtin_amdgcn_mfma_f32_16x16x32_bf16(a, b0, acc0, 0, 0, 0); acc1 = __builtin_amdgcn_mfma_f32_16x16x32_bf16(a, b1, acc1, 0, 0, 0); }
#pragma unroll
        for (int j = 0; j < 4; ++j) { Sc[(kg * 4 + j) * 256 + (2 * wave) * 16 + r] = acc0[j]; Sc[(kg * 4 + j) * 256 + (2 * wave + 1) * 16 + r] = acc1[j]; }
    }
    __syncthreads();
    const int sp = tid & 127, dir = sp >> 6, pp = sp & 63, seg = tid >> 7;
    const f32x2 a16 = APOW[((size_t)(dir * 32 + g) * 64 + pp) * 17 + 16];
    const float* S = (const float*)(p.ws + WS_S) + (size_t)item * 65536 + dir * 128 + pp;
    {
        float hr = 0.f, hi = 0.f;
#pragma unroll 8
        for (int q = 0; q < 64; ++q) { const int c = dir ? 255 - (seg * 64 + q) : seg * 64 + q; const float sr = S[c * 256], si = S[c * 256 + 64];
            const float nr = a16[0] * hr - a16[1] * hi + sr, ni = a16[0] * hi + a16[1] * hr + si; hr = nr; hi = ni; }
        Tseg[seg * 128 + sp] = (f32x2){hr, hi};
        if (seg == 0) { float cr = 0.f, ci = 0.f;
#pragma unroll 4
            for (int q = 0; q < 16; ++q) { const int cc = dir ? 15 - q : q; const float sr = Sc[cc * 256 + dir * 128 + pp], si = Sc[cc * 256 + dir * 128 + 64 + pp];
                const float nr = a16[0] * cr - a16[1] * ci + sr, ni = a16[0] * ci + a16[1] * cr + si; cr = nr; ci = ni; }
            H0[sp] = (f32x2){cr, ci}; }
    }
    __syncthreads();
    {
        f32x2 a64 = a16;
#pragma unroll
        for (int i = 0; i < 6; ++i) a64 = (f32x2){a64[0] * a64[0] - a64[1] * a64[1], 2.f * a64[0] * a64[1]};
        f32x2 h = H0[sp];
        for (int s2 = 0; s2 < seg; ++s2) { const f32x2 T = Tseg[s2 * 128 + sp]; h = (f32x2){a64[0] * h[0] - a64[1] * h[1] + T[0], a64[0] * h[1] + a64[1] * h[0] + T[1]}; }
        bf16* Xh = (bf16*)(p.ws + WS_X) + (size_t)item * 256 * 512 + 256 + dir * 128 + pp;
        float hr = h[0], hi = h[1];
#pragma unroll 8
        for (int q = 0; q < 64; ++q) { const int c = dir ? 255 - (seg * 64 + q) : seg * 64 + q;
            Xh[(size_t)c * 512] = (bf16)f2bf(hr); Xh[(size_t)c * 512 + 64] = (bf16)f2bf(hi);
            const float sr = S[c * 256], si = S[c * 256 + 64];
            const float nr = a16[0] * hr - a16[1] * hi + sr, ni = a16[0] * hi + a16[1] * hr + si; hr = nr; hi = ni; }
    }
    asm volatile("s_waitcnt vmcnt(0)" ::: "memory");
    __syncthreads();
}

__device__ __forceinline__ void conv_item(const Params& p, const LAS float* cw, int item, int lane) {
    const bf16* HC = (const bf16*)(p.ws + WS_HC); bf16* YC = (bf16*)(p.ws + WS_YC);
    const int rb = item & 7, w = (item >> 3) & 63, b = item >> 9;
    float acc[8][8];
#pragma unroll
    for (int i = 0; i < 8; ++i)
#pragma unroll
        for (int j = 0; j < 8; ++j) acc[i][j] = 0.f;
    const size_t base = ((size_t)b * SEQ + w) * 512 + lane * 8;
#pragma unroll 1
    for (int d = -15; d <= 22; ++d) {
        const int rin = rb * 8 + d;
        if (rin >= 0 && rin < 64) {
            const v4u hv = *(const v4u*)(HC + base + (size_t)rin * 64 * 512);
            const float h[8] = {bflo(hv.x), bfhi(hv.x), bflo(hv.y), bfhi(hv.y), bflo(hv.z), bfhi(hv.z), bflo(hv.w), bfhi(hv.w)};
            const LAS float* wp = cw + (d + 22) * 512 + lane * 8;
#pragma unroll
            for (int ro = 0; ro < 8; ++ro) { const f32x4 w0 = *(const LAS f32x4*)(wp - ro * 512), w1 = *(const LAS f32x4*)(wp - ro * 512 + 4);
#pragma unroll
                for (int j = 0; j < 4; ++j) { acc[ro][j] += h[j] * w0[j]; acc[ro][4 + j] += h[4 + j] * w1[j]; } }
        }
    }
    const f32x4 cb0 = *(const f32x4*)(p.conv_b + lane * 8), cb1 = *(const f32x4*)(p.conv_b + lane * 8 + 4);
    const f32x4 lg0 = *(const f32x4*)(p.ln_g + lane * 8), lg1 = *(const f32x4*)(p.ln_g + lane * 8 + 4);
    const f32x4 lb0 = *(const f32x4*)(p.ln_b + lane * 8), lb1 = *(const f32x4*)(p.ln_b + lane * 8 + 4);
#pragma unroll
    for (int ro = 0; ro < 8; ++ro) {
        float v[8]; float s = 0.f;
#pragma unroll
        for (int j = 0; j < 4; ++j) { v[j] = acc[ro][j] + cb0[j]; v[4 + j] = acc[ro][4 + j] + cb1[j]; }
#pragma unroll
        for (int j = 0; j < 8; ++j) s += v[j];
        const float mean = wave_sum(s) * (1.0f / 512.0f); float qq = 0.f;
#pragma unroll
        for (int j = 0; j < 8; ++j) { v[j] -= mean; qq += v[j] * v[j]; }
        const float rstd = rsqrtf(wave_sum(qq) * (1.0f / 512.0f) + EPS_LN);
        float o[8];
#pragma unroll
        for (int j = 0; j < 4; ++j) { const float y0 = v[j] * rstd * lg0[j] + lb0[j], y1 = v[4 + j] * rstd * lg1[j] + lb1[j]; o[j] = y0 * sigmoidf_(y0); o[4 + j] = y1 * sigmoidf_(y1); }
        v4u ov; ov.x = pk2(o[0], o[1]); ov.y = pk2(o[2], o[3]); ov.z = pk2(o[4], o[5]); ov.w = pk2(o[6], o[7]);
        *(v4u*)(YC + ((size_t)b * SEQ + (rb * 8 + ro) * 64 + w) * 1024 + 512 + lane * 8) = ov;
    }
}

__device__ __forceinline__ void phase_conv(const Params& p, LAS unsigned char* lds, int tid, int lane, int wave, int blk, int G) {
    LAS float* cw = (LAS float*)lds;
    for (int e = tid; e < 45 * 512; e += 512) { const int kk = e >> 9; cw[e] = (kk >= 7 && kk <= 37) ? p.conv_w[e - 7 * 512] : 0.f; }
    __syncthreads();
    for (int item = blk * 8 + wave; item < 4096; item += G * 8) conv_item(p, cw, item, lane);
}
__device__ __forceinline__ void phase_final(const Params& p, int lane, int wave, int blk, int G) {
    const int gw = blk * 8 + wave, NGW = G * 8;
    for (int m = gw; m < ML; m += NGW) {
        float* o = p.out + (size_t)m * DM; f32x4 v[4]; float ss = 0.f;
#pragma unroll
        for (int j = 0; j < 4; ++j) { v[j] = *(const f32x4*)(o + 4 * lane + 256 * j); ss += (v[j][0] * v[j][0] + v[j][1] * v[j][1]) + (v[j][2] * v[j][2] + v[j][3] * v[j][3]); }
        const float rstd = rsqrtf(wave_sum(ss) * (1.0f / DM) + EPS_RMS);
#pragma unroll
        for (int j = 0; j < 4; ++j) { const f32x4 g = *(const f32x4*)(p.final_g + 4 * lane + 256 * j); *(f32x4*)(o + 4 * lane + 256 * j) = v[j] * rstd * g; }
    }
}

#ifndef REP_P0
#define REP_P0 1
#endif
#ifndef REP_P1
#define REP_P1 1
#endif
#ifndef REP_G1
#define REP_G1 1
#endif
#ifndef REP_S5A
#define REP_S5A 1
#endif
#ifndef REP_CONV
#define REP_CONV 1
#endif
#ifndef REP_S5C
#define REP_S5C 1
#endif
#ifndef REP_GLU
#define REP_GLU 1
#endif
#ifndef REP_OUT
#define REP_OUT 1
#endif
#ifndef REP_UP
#define REP_UP 1
#endif
#ifndef REP_DOWN
#define REP_DOWN 1
#endif
#ifndef NSYNC_EXTRA
#define NSYNC_EXTRA 0
#endif
__global__ void __launch_bounds__(512, 2) fwd_kernel(Params p) {
    extern __shared__ __attribute__((aligned(16))) unsigned char lds_raw[];
    cg::grid_group grid = cg::this_grid();
    LAS unsigned char* lds = (LAS unsigned char*)lds_raw;
    const int blk = blockIdx.x, G = gridDim.x;
#define TIDX ((int)threadIdx.x)
#define TL int t_ = TIDX; asm volatile("" : "+v"(t_)); const int tid = t_, lane = t_ & 63, wave = __builtin_amdgcn_readfirstlane(t_ >> 6); (void)tid; (void)lane; (void)wave;
    unsigned char* ws = p.ws;
    if (threadIdx.x < 2) ((volatile LAS unsigned*)(lds + LDS_MISC))[threadIdx.x] = 0u;
    if (blk == 0) for (int e = threadIdx.x; e < XCD_BAR_WORDS; e += 512) ((unsigned*)(ws + WS_BAR))[e] = 0u;
    __syncthreads();

    for (int rep = 0; rep < REP_P0; ++rep)
    { TL phase0(p, lds, tid, lane, wave, blk, G); }
    grid.sync();
    const XcdBarrier xbar = xcd_barrier_post((unsigned*)(ws + WS_BAR), (volatile LAS unsigned*)(lds + LDS_MISC));
    for (int rep = 0; rep < REP_P1; ++rep) {
    { TL phase1(p, lds, tid, lane, wave, blk, G); }
    { TL s5_tables(p, tid, blk, G); } }
    for (int rep = 0; rep < NSYNC_EXTRA; ++rep) xcd_barrier(xbar);
    xcd_barrier(xbar);
    for (int rep = 0; rep < REP_G1; ++rep)
    {
        pg8::Gemm g{(const bf16*)(ws + WS_A1), (const bf16*)(ws + WS_WIN), MT, INC, DM, DM}; pg8::G1Order S; S.init(G, blk);
        pg8::EpiG1 E{(bf16*)(ws + WS_X), (bf16*)(ws + WS_XC), (bf16*)(ws + WS_HC)};
        pg8::gemm_phase<pg8::EpiG1, pg8::G1Order, true, true>(lds, g, S, E, TIDX);
    }
    xcd_barrier(xbar);
    for (int rep = 0; rep < REP_S5A; ++rep)
    {
        pg8::Gemm g{(const bf16*)(ws + WS_X), (const bf16*)(ws + WS_WT), 65536, 256, 256, 512}; pg8::ItemOrder S{G, blk, 256};
        pg8::EpiS5A E{(float*)(ws + WS_S)};
        pg8::gemm_phase<pg8::EpiS5A, pg8::ItemOrder, true, true>(lds, g, S, E, TIDX);
    }
    for (int rep = 0; rep < REP_CONV; ++rep)
    { TL phase_conv(p, lds, tid, lane, wave, blk, G); }
    xcd_barrier(xbar);
    for (int rep = 0; rep < REP_S5C; ++rep)
    for (int item = blk; item < 256; item += G) {
        { TL s5_scan_item(p, lds, item, tid, lane, wave); }
        pg8::Gemm g{(const bf16*)(ws + WS_X), (const bf16*)(ws + WS_MET), 65536, 256, 512, 512}; pg8::OneUnit S{item, item & 31};
        pg8::EpiS5C E{(bf16*)(ws + WS_G)};
        pg8::gemm_phase<pg8::EpiS5C, pg8::OneUnit, true, true>(lds, g, S, E, TIDX);
    }
    xcd_barrier(xbar);
    for (int rep = 0; rep < REP_GLU; ++rep)
    {
        pg8::Gemm g{(const bf16*)(ws + WS_G), (const bf16*)(ws + WS_WGLU), ML, S5W, S5W, S5W}; pg8::StaticOrder S; S.init(ML, S5W, G, blk);
        pg8::EpiGlu E{(const bf16*)(ws + WS_G), (bf16*)(ws + WS_YC)};
        pg8::gemm_phase<pg8::EpiGlu, pg8::StaticOrder, true, true>(lds, g, S, E, TIDX);
    }
    xcd_barrier(xbar);
    for (int rep = 0; rep < REP_OUT; ++rep)
    {
        pg8::Gemm g{(const bf16*)(ws + WS_YC), (const bf16*)(ws + WS_WOUT), ML, DM, DM, DM}; pg8::StaticOrder S; S.init(ML, DM, G, blk);
        pg8::EpiOut E{p.x, (const float*)(ws + WS_MOD), p.norm2_g, (float*)(ws + WS_H1), (bf16*)(ws + WS_HS), (float*)(ws + WS_SS1)};
        pg8::gemm_phase<pg8::EpiOut, pg8::StaticOrder, true, true>(lds, g, S, E, TIDX);
    }
    xcd_barrier(xbar);
    for (int rep = 0; rep < REP_UP; ++rep)
    {
        pg8::Gemm g{(const bf16*)(ws + WS_HS), (const bf16*)(ws + WS_W1), ML, DFF, DM, DM}; pg8::StaticOrder S; S.init(ML, DFF, G, blk);
        pg8::EpiUp E{(const float*)(ws + WS_SS1), (const float*)(ws + WS_BIAS1), (bf16*)(ws + WS_HID)};
        pg8::gemm_phase<pg8::EpiUp, pg8::StaticOrder, true, true>(lds, g, S, E, TIDX);
    }
    xcd_barrier(xbar);
    for (int rep = 0; rep < REP_DOWN; ++rep)
    {
        pg8::Gemm g{(const bf16*)(ws + WS_HID), (const bf16*)(ws + WS_W2), ML, DM, DFF, DFF}; pg8::StaticOrder S; S.init(ML, DM, G, blk);
        pg8::EpiDown E{(const float*)(ws + WS_H1), (const float*)(ws + WS_MOD), p.out};
        pg8::gemm_phase<pg8::EpiDown, pg8::StaticOrder, true, true>(lds, g, S, E, TIDX);
    }
    xcd_barrier(xbar);
    { TL phase_final(p, lane, wave, blk, G); }
}

extern "C" void kernel_launch(void* const* d_in, const int* in_sizes, int n_in, void* d_out, int out_size, void* d_ws, size_t ws_size, hipStream_t stream) {
    static int grid = 0;
    if (grid == 0) {
        if (n_in != 26 || out_size != ML * DM || ws_size < WS_END) { fprintf(stderr, "kernel_launch: unexpected shapes (n_in %d out %d ws %zu)\n", n_in, out_size, ws_size); grid = -1; return; }
        int dev = 0, cus = 0, per_cu = 0;
        hipGetDevice(&dev);
        hipDeviceGetAttribute(&cus, hipDeviceAttributeMultiprocessorCount, dev);
        if (hipFuncSetAttribute((const void*)fwd_kernel, hipFuncAttributeMaxDynamicSharedMemorySize, LDS_BYTES) != hipSuccess) { fprintf(stderr, "kernel_launch: hipFuncSetAttribute failed\n"); grid = -1; return; }
        if (hipOccupancyMaxActiveBlocksPerMultiprocessor(&per_cu, (const void*)fwd_kernel, 512, LDS_BYTES) != hipSuccess || per_cu < 1) { fprintf(stderr, "kernel_launch: occupancy query says %d\n", per_cu); per_cu = 1; (void)hipGetLastError(); }
        grid = cus * per_cu;
    }
    if (grid < 0) return;
    Params p{};
    const float** f = (const float**)&p;
    for (int i = 0; i < 26; ++i) f[i] = (const float*)d_in[i];
    p.out = (float*)d_out; p.ws = (unsigned char*)d_ws;
    void* args[] = {&p};
    hipError_t e = hipLaunchCooperativeKernel((const void*)fwd_kernel, dim3(grid), dim3(512), args, LDS_BYTES, stream);
    if (e != hipSuccess) fprintf(stderr, "cooperative launch failed: %s (grid %d)\n", hipGetErrorString(e), grid);
}
```

```cpp
#include <hip/hip_runtime.h>
#include <hip/hip_cooperative_groups.h>
#include <cstdio>
#include <cstdint>
namespace cg = cooperative_groups;
#define GAS __attribute__((address_space(1)))
#define LAS __attribute__((address_space(3)))
typedef unsigned short bf16;
typedef unsigned v4u __attribute__((ext_vector_type(4)));
typedef unsigned v2u __attribute__((ext_vector_type(2)));
typedef float f32x4 __attribute__((ext_vector_type(4)));
typedef float f32x2 __attribute__((ext_vector_type(2)));
constexpr int DM = 1024, NB = 8, SEQ = 4096, NCTX = 256, ML = NB * SEQ, MC = NB * NCTX, MT = ML + MC;
constexpr int S5W = 512, CVW = 512, INC = 1536, DFF = 4096, NG = 32, NP = 64, NH = 16, CK = 31;
constexpr float EPS_RMS = 1e-6f, EPS_LN = 1e-5f;
constexpr size_t MiB = 1u << 20;
constexpr size_t WS_HID = 0;
constexpr size_t WS_A1 = 0, WS_S = 0;
constexpr size_t WS_X = 68 * MiB;
constexpr size_t WS_XC = 132 * MiB;
constexpr size_t WS_HC = 134 * MiB, WS_G = 134 * MiB;
constexpr size_t WS_YC = 166 * MiB;
constexpr size_t WS_H1 = 256 * MiB;
constexpr size_t WS_HS = 384 * MiB;
constexpr size_t WS_WIN = 448 * MiB, WS_WGLU = 451 * MiB, WS_WOUT = 452 * MiB, WS_W1 = 454 * MiB, WS_W2 = 462 * MiB;
constexpr size_t WS_MOD = 470 * MiB, WS_MODC = WS_MOD + 256 * 1024, WS_BIAS1 = WS_MOD + 512 * 1024;
constexpr size_t WS_BAR = WS_MOD + 768 * 1024;
constexpr size_t WS_SS1 = 471 * MiB;
constexpr size_t WS_APOW = 473 * MiB;
constexpr size_t WS_BB = 474 * MiB;
constexpr size_t WS_KT = 475 * MiB;
constexpr size_t WS_WT = 476 * MiB;
constexpr size_t WS_MET = 480 * MiB;
constexpr size_t WS_END = 512 * MiB;
constexpr int LDS_BYTES = 139264;
constexpr int LDS_MISC = 131072 + 256;

struct Params {
    const float *x, *c, *ctx, *c_ctx, *ada_w, *ada_b, *norm1_g, *w_in, *lam_re, *lam_im, *log_dt, *b_re, *b_im, *c_re, *c_im, *s5_d, *w_glu,
                *conv_w, *conv_b, *ln_g, *ln_b, *w_out, *norm2_g, *w1, *w2, *final_g;
    float* out; unsigned char* ws;
};

__device__ __forceinline__ unsigned f2bf(float f) { unsigned u = __builtin_bit_cast(unsigned, f); return (u + 0x7fffu + ((u >> 16) & 1u)) >> 16; }
__device__ __forceinline__ unsigned pk2(float lo, float hi) { return f2bf(lo) | (f2bf(hi) << 16); }
__device__ __forceinline__ float bflo(unsigned w) { return __builtin_bit_cast(float, w << 16); }
__device__ __forceinline__ float bfhi(unsigned w) { return __builtin_bit_cast(float, w & 0xffff0000u); }
__device__ __forceinline__ float wave_sum(float v) {
#pragma unroll
    for (int o = 1; o < 64; o <<= 1) v += __shfl_xor(v, o);
    return v;
}
__device__ __forceinline__ float sigmoidf_(float g) { return __builtin_amdgcn_rcpf(1.0f + __expf(-g)); }
__device__ __forceinline__ float gelu_tanh(float y) {
    const float z = 0.7978845608028654f * (y + 0.044715f * y * y * y);
    const float th = 1.0f - 2.0f * __builtin_amdgcn_rcpf(1.0f + __expf(2.0f * z));
    return 0.5f * y * (1.0f + th);
}
#define LDS_WAIT() asm volatile("s_waitcnt lgkmcnt(0)" ::: "memory")

#define XB_TMO      128
#define XB_XCNT(j)  (256  + 64 * (j))
#define XB_XSUB(j)  (1280 + 64 * (j))
#define XB_XGEN(j)  (2304 + 64 * (j))
#define XB_TOP      3328
#define XB_TOPGEN   3392
#define XCD_BAR_WORDS 3456
#define XB_SPIN_CAP (1u << 18)

__device__ __forceinline__ unsigned xb_ld(unsigned* p)              { return __hip_atomic_load(p, __ATOMIC_RELAXED, __HIP_MEMORY_SCOPE_AGENT); }
__device__ __forceinline__ unsigned xb_add(unsigned* p, unsigned v) { return __hip_atomic_fetch_add(p, v, __ATOMIC_RELAXED, __HIP_MEMORY_SCOPE_AGENT); }
__device__ __forceinline__ unsigned xb_xcc_id() { return (unsigned)__builtin_amdgcn_s_getreg((3 << 11) | 20) & 0xFu; }
#define XB_SPIN(cond, bar) do { unsigned _sp = 0; while (cond) { __builtin_amdgcn_s_sleep(1); \
    if ((++_sp & 255u) == 0u) { if (xb_ld(&(bar)[XB_TMO])) break; if (_sp > XB_SPIN_CAP) { atomicAdd(&(bar)[XB_TMO], 1u); break; } } } } while (0)

struct XcdBarrier {
    unsigned* bar; unsigned x;
    volatile LAS unsigned* st;
};

__device__ __forceinline__ XcdBarrier xcd_barrier_post(unsigned* bar, volatile LAS unsigned* st) {
    XcdBarrier b; b.bar = bar; b.x = xb_xcc_id(); b.st = st;
    if (threadIdx.x == 0) (void)xb_add(&bar[XB_XCNT(b.x)], 1u);
    return b;
}
__device__ __forceinline__ void xcd_barrier_complete(unsigned* bar, unsigned x, unsigned& nloc, unsigned& nx) {
    const unsigned G = gridDim.x * gridDim.y * gridDim.z;
    unsigned sum, cnt, mine, sp = 0u;
    for (;;) {
        sum = 0u; cnt = 0u; mine = 0u;
#pragma unroll
        for (unsigned j = 0; j < 16; ++j) { const unsigned c = xb_ld(&bar[XB_XCNT(j)]); sum += c; cnt += (c > 0u) ? 1u : 0u; mine = (j == x) ? c : mine; }
        if (sum == G) break;
        __builtin_amdgcn_s_sleep(1);
        if ((++sp & 255u) == 0u) { if (xb_ld(&bar[XB_TMO])) break; if (sp > XB_SPIN_CAP) { atomicAdd(&bar[XB_TMO], 1u); break; } }
    }
    nloc = mine > 0u ? mine : 1u; nx = cnt > 0u ? cnt : 1u;
}

__device__ __forceinline__ void xcd_barrier(const XcdBarrier& b) {
    asm volatile("s_waitcnt vmcnt(0)" ::: "memory");
    __syncthreads();
    if (threadIdx.x == 0) {
        unsigned* bar = b.bar;
        __builtin_amdgcn_s_waitcnt(0);
        unsigned nloc = b.st[0], nx = b.st[1];
        if (nloc == 0u) { xcd_barrier_complete(bar, b.x, nloc, nx); b.st[0] = nloc; b.st[1] = nx; }
        const unsigned old = xb_add(&bar[XB_XSUB(b.x)], 1u);
        const unsigned gen = old / nloc;
        if (old + 1u == (gen + 1u) * nloc) {
            __builtin_amdgcn_fence(__ATOMIC_RELEASE, "agent");
            asm volatile("s_waitcnt vmcnt(0)" ::: "memory");
            const unsigned og = xb_add(&bar[XB_TOP], 1u);
            const unsigned tg = og / nx;
            if (og + 1u == (tg + 1u) * nx) xb_add(&bar[XB_TOPGEN], 1u);
            else XB_SPIN(xb_ld(&bar[XB_TOPGEN]) == tg, bar);
            __builtin_amdgcn_fence(__ATOMIC_ACQUIRE, "agent");
            xb_add(&bar[XB_XGEN(b.x)], 1u);
            asm volatile("s_waitcnt vmcnt(0)" ::: "memory");
        } else {
            XB_SPIN(xb_ld(&bar[XB_XGEN(b.x)]) == gen, bar);
            __builtin_amdgcn_fence(__ATOMIC_ACQUIRE, "agent");
            asm volatile("s_waitcnt vmcnt(0)" ::: "memory");
        }
    }
    __syncthreads();
}
namespace pg8 {
#define PG8_LAS __attribute__((address_space(3)))
typedef unsigned short bf16_t;
typedef short bf16x8 __attribute__((ext_vector_type(8)));
typedef float f32x4 __attribute__((ext_vector_type(4)));
typedef unsigned u32x4 __attribute__((ext_vector_type(4)));
constexpr int BM = 256, BK = 64, HALF = 128, HTB = HALF * BK * 2  , STAGE_BYTES = 8 * HTB, NXCD = 8, WGM = 8;

__host__ __device__ __forceinline__ int lds_byte(int r, int c) { const int st = (r >> 4) * 2 + (c >> 5), rr = r & 15, cc = c & 31, ob = rr * 64 + cc * 2; return st * 1024 + (ob ^ (((ob >> 9) & 1) << 5)); }
__host__ __device__ __forceinline__ void stage_rc(int b, int& R, int& C) { const int st = b / 1024, sb = b % 1024, swz = sb ^ (((sb >> 9) & 1) << 5); R = (st >> 1) * 16 + swz / 64; C = (st & 1) * 32 + (swz % 64) / 2; }
__host__ __device__ __forceinline__ int perm32(int rho) { const int n = rho >> 4, i = rho & 15; return 8 * (i >> 2) + 4 * n + (i & 3); }

struct Unit { int pm, pn; };
struct Gemm { const bf16_t* A; const bf16_t* Bt; int M, N, K, lda; };

struct StaticOrder {
    int nM, nN, nwg, G, c;
    __host__ __device__ void init(int M, int N, int G_, int c_) { nM = M / BM; nN = N / BM; nwg = nM * nN; G = G_; c = c_; }
    __host__ __device__ bool next(int i, Unit& u) const {
        const long L = (long)i * G + c; if (L >= nwg) return false;
        int wgid = (int)L; { const int q = nwg / NXCD, r = nwg % NXCD, xcd = wgid % NXCD, off = wgid / NXCD; wgid = (xcd < r ? xcd * (q + 1) : r * (q + 1) + (xcd - r) * q) + off; }
        const int nig = WGM * nN, gid = wgid / nig, fm = gid * WGM, gsz = (nM - fm) < WGM ? (nM - fm) : WGM;
        u.pm = fm + ((wgid % nig) % gsz); u.pn = (wgid % nig) / gsz; return true;
    }
    __device__ __forceinline__ void a_ready(const Unit&) const {}
    __device__ __forceinline__ void done(const Unit&) const {}
};

__device__ __forceinline__ unsigned cvt_pk_bf16(float lo, float hi) { unsigned r; asm volatile("v_cvt_pk_bf16_f32 %0, %1, %2" : "=v"(r) : "v"(lo), "v"(hi)); return r; }
typedef float f32x2 __attribute__((ext_vector_type(2)));
}
namespace pg8 {
typedef unsigned u32x4 __attribute__((ext_vector_type(4)));
typedef unsigned u32x2 __attribute__((ext_vector_type(2)));
struct EpiG1 {
    static constexpr bool PERM = true, AFTER_DRAIN = false;
    bf16_t* X; bf16_t* XC; bf16_t* HC;
    __device__ __forceinline__ void operator()(const f32x4 (&acc)[2][2][4][2], const Unit& u, int wr, int wc, int fr, int fq) const {
        const int row0 = u.pm * BM + wr * 64 + fr;
        if (u.pn < 2) {
            const int col0 = u.pn * BM + wc * 32 + 8 * fq;
#pragma unroll
            for (int ai = 0; ai < 2; ++ai)
#pragma unroll
                for (int m = 0; m < 4; ++m) { const int row = row0 + ai * HALF + m * 16;
#pragma unroll
                    for (int bj = 0; bj < 2; ++bj) { const int col = col0 + bj * HALF, g = col >> 4, j0 = col & 15; bf16_t* dst;
                        if (row < ML) { const int b = row >> 12, c = (row >> 4) & 255, s = row & 15; dst = X + ((size_t)((b * 32 + g) * 256 + c)) * 512 + s * 16 + j0; }
                        else { const int rr = row - ML, b = rr >> 8, c = (rr >> 4) & 15, s = rr & 15; dst = XC + ((size_t)((b * 32 + g) * 16 + c)) * 256 + s * 16 + j0; }
                        const f32x4 v0 = acc[ai][bj][m][0], v1 = acc[ai][bj][m][1]; u32x4 w;
                        w.x = cvt_pk_bf16(v0[0], v0[1]); w.y = cvt_pk_bf16(v0[2], v0[3]); w.z = cvt_pk_bf16(v1[0], v1[1]); w.w = cvt_pk_bf16(v1[2], v1[3]);
                        *(u32x4*)dst = w; } }
        } else {
            const int ch0 = (u.pn - 2) * HALF + wc * 32 + 8 * fq;
#pragma unroll
            for (int ai = 0; ai < 2; ++ai)
#pragma unroll
                for (int m = 0; m < 4; ++m) { bf16_t* rowp = HC + (size_t)(row0 + ai * HALF + m * 16) * 512 + ch0; float h[8];
#pragma unroll
                    for (int n = 0; n < 2; ++n)
#pragma unroll
                        for (int j = 0; j < 4; ++j) h[n * 4 + j] = acc[ai][0][m][n][j] * sigmoidf_(acc[ai][1][m][n][j]);
                    u32x4 w; w.x = cvt_pk_bf16(h[0], h[1]); w.y = cvt_pk_bf16(h[2], h[3]); w.z = cvt_pk_bf16(h[4], h[5]); w.w = cvt_pk_bf16(h[6], h[7]);
                    *(u32x4*)rowp = w; }
        }
    }
};
struct EpiS5A {
    static constexpr bool PERM = false, AFTER_DRAIN = false;
    float* S;
    __device__ __forceinline__ void operator()(const f32x4 (&acc)[2][2][4][2], const Unit& u, int wr, int wc, int fr, int fq) const {
        float* rp = S + ((size_t)u.pm * 256 + wr * 64 + fr) * 256 + wc * 32 + 4 * fq;
#pragma unroll
        for (int ai = 0; ai < 2; ++ai) {
#pragma unroll
            for (int m = 0; m < 4; ++m) {
#pragma unroll
                for (int bj = 0; bj < 2; ++bj)
#pragma unroll
                    for (int n = 0; n < 2; ++n) *(f32x4*)(rp + bj * HALF + n * 16) = acc[ai][bj][m][n];
                rp += 16 * 256; asm volatile("" : "+v"(rp)); }
            rp += 64 * 256; }
    }
};
struct EpiS5C {
    static constexpr bool PERM = true, AFTER_DRAIN = false;
    bf16_t* G;
    __device__ __forceinline__ void operator()(const f32x4 (&acc)[2][2][4][2], const Unit& u, int wr, int wc, int fr, int fq) const {
        const int b = u.pm >> 5, g = u.pm & 31;
#pragma unroll
        for (int ai = 0; ai < 2; ++ai)
#pragma unroll
            for (int m = 0; m < 4; ++m) { const int c = ai * HALF + wr * 64 + m * 16 + fr;
#pragma unroll
                for (int bj = 0; bj < 2; ++bj) { const int o0 = bj * HALF + wc * 32 + 8 * fq, tl = o0 >> 4, i0 = o0 & 15;
                    const f32x4 v0 = acc[ai][bj][m][0], v1 = acc[ai][bj][m][1]; u32x4 w;
                    w.x = cvt_pk_bf16(gelu_tanh(v0[0]), gelu_tanh(v0[1])); w.y = cvt_pk_bf16(gelu_tanh(v0[2]), gelu_tanh(v0[3]));
                    w.z = cvt_pk_bf16(gelu_tanh(v1[0]), gelu_tanh(v1[1])); w.w = cvt_pk_bf16(gelu_tanh(v1[2]), gelu_tanh(v1[3]));
                    *(u32x4*)(G + ((size_t)(b * SEQ + c * 16 + tl)) * 512 + g * 16 + i0) = w; } }
    }
};
struct EpiGlu {
    static constexpr bool PERM = true, AFTER_DRAIN = false;
    const bf16_t* G; bf16_t* YC;
    __device__ __forceinline__ void operator()(const f32x4 (&acc)[2][2][4][2], const Unit& u, int wr, int wc, int fr, int fq) const {
        const int row0 = u.pm * BM + wr * 64 + fr, col0 = u.pn * BM + wc * 32 + 8 * fq;
#pragma unroll
        for (int ai = 0; ai < 2; ++ai)
#pragma unroll
            for (int m = 0; m < 4; ++m) { const size_t row = (size_t)(row0 + ai * HALF + m * 16);
#pragma unroll
                for (int bj = 0; bj < 2; ++bj) { const u32x4 gv = *(const u32x4*)(G + row * 512 + col0 + bj * HALF);
                    const f32x4 v0 = acc[ai][bj][m][0], v1 = acc[ai][bj][m][1]; u32x4 w;
                    w.x = cvt_pk_bf16(bflo(gv.x) * sigmoidf_(v0[0]), bfhi(gv.x) * sigmoidf_(v0[1]));
                    w.y = cvt_pk_bf16(bflo(gv.y) * sigmoidf_(v0[2]), bfhi(gv.y) * sigmoidf_(v0[3]));
                    w.z = cvt_pk_bf16(bflo(gv.z) * sigmoidf_(v1[0]), bfhi(gv.z) * sigmoidf_(v1[1]));
                    w.w = cvt_pk_bf16(bflo(gv.w) * sigmoidf_(v1[2]), bfhi(gv.w) * sigmoidf_(v1[3]));
                    *(u32x4*)(YC + row * 1024 + col0 + bj * HALF) = w; } }
    }
};
struct EpiOut {
    static constexpr bool PERM = false, AFTER_DRAIN = false;
    const float* x; const float* mod; const float* n2g; float* H1; bf16_t* HS; float* SS1;
    __device__ __forceinline__ void operator()(const f32x4 (&acc)[2][2][4][2], const Unit& u, int wr, int wc, int fr, int fq) const {
        const int row0 = u.pm * BM + wr * 64 + fr, col0 = u.pn * BM + wc * 32 + 4 * fq;
        const int b = (u.pm * BM) >> 12;
        const float* mb = mod + (size_t)b * 6144;
        f32x4 g1v[2][2], wsv[2][2];
#pragma unroll
        for (int bj = 0; bj < 2; ++bj)
#pragma unroll
            for (int n = 0; n < 2; ++n) { const int c = col0 + bj * HALF + n * 16;
                g1v[bj][n] = *(const f32x4*)(mb + 2048 + c);
                wsv[bj][n] = *(const f32x4*)(n2g + c) * (*(const f32x4*)(mb + 4096 + c) + 1.0f); }
#pragma unroll
        for (int ai = 0; ai < 2; ++ai)
#pragma unroll
            for (int m = 0; m < 4; ++m) { const int row = row0 + ai * HALF + m * 16; const size_t off = (size_t)row * DM + col0; float ss = 0.f;
#pragma unroll
                for (int bj = 0; bj < 2; ++bj)
#pragma unroll
                    for (int n = 0; n < 2; ++n) { const size_t o = off + bj * HALF + n * 16;
                        const f32x4 h1 = *(const f32x4*)(x + o) + g1v[bj][n] * acc[ai][bj][m][n];
                        *(f32x4*)(H1 + o) = h1; ss += (h1[0] * h1[0] + h1[1] * h1[1]) + (h1[2] * h1[2] + h1[3] * h1[3]);
                        const f32x4 hs = h1 * wsv[bj][n]; u32x2 w; w.x = cvt_pk_bf16(hs[0], hs[1]); w.y = cvt_pk_bf16(hs[2], hs[3]);
                        *(u32x2*)(HS + o) = w; }
                ss += __shfl_xor(ss, 16); ss += __shfl_xor(ss, 32);
                if (fq == 0) SS1[(size_t)row * 16 + u.pn * 4 + wc] = ss; }
    }
};
struct EpiUp {
    static constexpr bool PERM = true, AFTER_DRAIN = false;
    const float* SS1; const float* bias1; bf16_t* HID;
    __device__ __forceinline__ void operator()(const f32x4 (&acc)[2][2][4][2], const Unit& u, int wr, int wc, int fr, int fq) const {
        const int row0 = u.pm * BM + wr * 64 + fr, col0 = u.pn * BM + wc * 32 + 8 * fq;
        const int b = (u.pm * BM) >> 12;
        f32x4 bv[2][2];
#pragma unroll
        for (int bj = 0; bj < 2; ++bj)
#pragma unroll
            for (int n = 0; n < 2; ++n) bv[bj][n] = *(const f32x4*)(bias1 + (size_t)b * DFF + col0 + bj * HALF + 4 * n);
#pragma unroll
        for (int ai = 0; ai < 2; ++ai)
#pragma unroll
            for (int m = 0; m < 4; ++m) { const int row = row0 + ai * HALF + m * 16;
                const f32x4* sp = (const f32x4*)(SS1 + (size_t)row * 16); const f32x4 s0 = sp[0], s1 = sp[1], s2 = sp[2], s3 = sp[3];
                const float ss = ((s0[0] + s0[1]) + (s0[2] + s0[3])) + ((s1[0] + s1[1]) + (s1[2] + s1[3])) + ((s2[0] + s2[1]) + (s2[2] + s2[3])) + ((s3[0] + s3[1]) + (s3[2] + s3[3]));
                const float rstd = rsqrtf(ss * (1.0f / DM) + EPS_RMS);
                bf16_t* rowp = HID + (size_t)row * DFF + col0;
#pragma unroll
                for (int bj = 0; bj < 2; ++bj) { f32x4 v0 = acc[ai][bj][m][0] * rstd + bv[bj][0], v1 = acc[ai][bj][m][1] * rstd + bv[bj][1];
#pragma unroll
                    for (int j = 0; j < 4; ++j) { const float a = fmaxf(v0[j], 0.f), c = fmaxf(v1[j], 0.f); v0[j] = a * a; v1[j] = c * c; }
                    u32x4 w; w.x = cvt_pk_bf16(v0[0], v0[1]); w.y = cvt_pk_bf16(v0[2], v0[3]); w.z = cvt_pk_bf16(v1[0], v1[1]); w.w = cvt_pk_bf16(v1[2], v1[3]);
                    *(u32x4*)(rowp + bj * HALF) = w; } }
    }
};
struct EpiDown {
    static constexpr bool PERM = false, AFTER_DRAIN = false;
    const float* H1; const float* mod; float* out;
    __device__ __forceinline__ void operator()(const f32x4 (&acc)[2][2][4][2], const Unit& u, int wr, int wc, int fr, int fq) const {
        const int row0 = u.pm * BM + wr * 64 + fr, col0 = u.pn * BM + wc * 32 + 4 * fq;
        const int b = (u.pm * BM) >> 12;
        const float* mb = mod + (size_t)b * 6144 + 5120;
        f32x4 g2v[2][2];
#pragma unroll
        for (int bj = 0; bj < 2; ++bj)
#pragma unroll
            for (int n = 0; n < 2; ++n) g2v[bj][n] = *(const f32x4*)(mb + col0 + bj * HALF + n * 16);
#pragma unroll
        for (int ai = 0; ai < 2; ++ai)
#pragma unroll
            for (int m = 0; m < 4; ++m) { const size_t off = (size_t)(row0 + ai * HALF + m * 16) * DM + col0;
#pragma unroll
                for (int bj = 0; bj < 2; ++bj)
#pragma unroll
                    for (int n = 0; n < 2; ++n) { const size_t o = off + bj * HALF + n * 16;
                        *(f32x4*)(out + o) = *(const f32x4*)(H1 + o) + g2v[bj][n] * acc[ai][bj][m][n]; } }
    }
};
struct G1Order {
    StaticOrder so;
    __device__ void init(int G, int c) { so.init(ML, INC, G, c); }
    __device__ bool next(int i, Unit& u) const {
        const long L = (long)i * so.G + so.c;
        if (L < so.nwg) return so.next(i, u);
        const int e = (int)(L - so.nwg); if (e >= 16) return false;
        u.pm = 128 + (e >> 1); u.pn = e & 1; return true;
    }
    __device__ __forceinline__ void a_ready(const Unit&) const {}
    __device__ __forceinline__ void done(const Unit&) const {}
};
struct ItemOrder {
    int G, c, n;
    __device__ bool next(int i, Unit& u) const { const int it = c + i * G; if (it >= n) return false; u.pm = it; u.pn = it & 31; return true; }
    __device__ __forceinline__ void a_ready(const Unit&) const {}
    __device__ __forceinline__ void done(const Unit&) const {}
};
struct OneUnit {
    int pm, pn;
    __device__ bool next(int i, Unit& u) const { if (i) return false; u.pm = pm; u.pn = pn; return true; }
    __device__ __forceinline__ void a_ready(const Unit&) const {}
    __device__ __forceinline__ void done(const Unit&) const {}
};
}
namespace pg8 {
template <class Epi, class Sched, bool ALIGN_EPI = false, bool SP2 = false>
__device__ __forceinline__ void gemm_phase(PG8_LAS unsigned char* lds, const Gemm g, const Sched& S, const Epi& E, int tid_in) {
    int tid_l = tid_in; asm volatile("" : "+v"(tid_l));
    const int tid = tid_l, wid = __builtin_amdgcn_readfirstlane(tid >> 6), lane = tid & 63, wr = wid >> 2, wc = wid & 3, fr = lane & 15, fq = lane >> 4;
    const int K = g.K; int nt_l = K / BK; asm volatile("" : "+s"(nt_l)); const int nt = nt_l;
    unsigned voffA[2], voffB[2];
#pragma unroll
    for (int i = 0; i < 2; ++i) { int R, C; stage_rc(tid * 16 + i * 8192, R, C); const int Rb = Epi::PERM ? ((R & ~31) + perm32(R & 31)) : R;
        voffA[i] = (unsigned)(R * g.lda + C) * 2u; voffB[i] = (unsigned)(Rb * K + C) * 2u; }
    const size_t kstep = (size_t)(BK * 2);
    const size_t hstep = (size_t)HALF * K * 2; const size_t hstepA = (size_t)HALF * g.lda * 2; const size_t tstepA = 2 * hstepA;
    const size_t tstep = 2 * hstep;
    const unsigned ldsw = (unsigned)wid * 1024u;
    const int aoff = lds_byte(wr * 64 + fr, fq * 8), boff = lds_byte(wc * 32 + fr, fq * 8);
#define PG8_SA(b, h) (((b) * 2 + (h)) * HTB)
#define PG8_SB(b, h) ((4 + (b) * 2 + (h)) * HTB)
#define PG8_STAGE(bufoff, gbase, voff) do { _Pragma("unroll") for (int _i = 0; _i < 2; ++_i) \
        __builtin_amdgcn_global_load_lds((const unsigned*)((const char*)(gbase) + (voff)[_i]), (PG8_LAS unsigned*)(lds + (bufoff) + ldsw + _i * 8192), 16, 0, 0); } while (0)
#define PG8_LDA(dst, b, h) do { _Pragma("unroll") for (int m = 0; m < 4; ++m) _Pragma("unroll") for (int k = 0; k < 2; ++k) dst[m][k] = *(const PG8_LAS bf16x8*)(lds + PG8_SA(b, h) + aoff + m * 2048 + k * 1024); } while (0)
#define PG8_LDB(dst, b, h) do { _Pragma("unroll") for (int n = 0; n < 2; ++n) _Pragma("unroll") for (int k = 0; k < 2; ++k) dst[n][k] = *(const PG8_LAS bf16x8*)(lds + PG8_SB(b, h) + boff + n * 2048 + k * 1024); } while (0)
#define PG8_MMA(ai, bj, At, Bt) do { __builtin_amdgcn_s_setprio(1); _Pragma("unroll") for (int m = 0; m < 4; ++m) _Pragma("unroll") for (int n = 0; n < 2; ++n) _Pragma("unroll") for (int k = 0; k < 2; ++k) \
        acc[ai][bj][m][n] = __builtin_amdgcn_mfma_f32_16x16x32_bf16(Bt[n][k], At[m][k], acc[ai][bj][m][n], 0, 0, 0); __builtin_amdgcn_s_setprio(0); } while (0)
#define PG8_WAIT_V(n) asm volatile("s_waitcnt vmcnt(" #n ")" ::: "memory")
#define PG8_WAIT_L(n) asm volatile("s_waitcnt lgkmcnt(" #n ")" ::: "memory")
#define PG8_BAR __builtin_amdgcn_s_barrier()
#define PG8_SCHED __builtin_amdgcn_sched_barrier(0)
    Unit cur, nxt; int ui = 0;
    if (!S.next(0, cur)) return;
    f32x4 acc[2][2][4][2];
#pragma unroll
    for (int a = 0; a < 2; ++a)
#pragma unroll
        for (int b = 0; b < 2; ++b)
#pragma unroll
            for (int m = 0; m < 4; ++m)
#pragma unroll
                for (int n = 0; n < 2; ++n) acc[a][b][m][n] = (f32x4){0.f, 0.f, 0.f, 0.f};
    bf16x8 At[4][2], B0[2][2], B1[2][2];
    const char* cA = (const char*)g.A + (size_t)cur.pm * tstepA; const char* cB = (const char*)g.Bt + (size_t)cur.pn * tstep;
    S.a_ready(cur);
    if constexpr (SP2) {
        PG8_STAGE(PG8_SB(0, 0), cB, voffB); PG8_STAGE(PG8_SB(0, 1), cB + hstep, voffB); PG8_STAGE(PG8_SA(0, 0), cA, voffA); PG8_STAGE(PG8_SA(0, 1), cA + hstepA, voffA);
        if (wr == 1) PG8_BAR;
        PG8_WAIT_V(2); PG8_BAR;
        PG8_STAGE(PG8_SB(1, 0), cB + kstep, voffB); PG8_STAGE(PG8_SA(1, 0), cA + kstep, voffA); PG8_STAGE(PG8_SB(1, 1), cB + hstep + kstep, voffB);
        PG8_WAIT_V(6); PG8_BAR;
    } else {
        PG8_STAGE(PG8_SB(0, 0), cB, voffB); PG8_STAGE(PG8_SA(0, 0), cA, voffA); PG8_STAGE(PG8_SB(0, 1), cB + hstep, voffB); PG8_STAGE(PG8_SA(0, 1), cA + hstepA, voffA);
        if (wr == 1) PG8_BAR;
        PG8_WAIT_V(4); PG8_BAR;
        PG8_STAGE(PG8_SB(1, 0), cB + kstep, voffB); PG8_STAGE(PG8_SA(1, 0), cA + kstep, voffA); PG8_STAGE(PG8_SB(1, 1), cB + hstep + kstep, voffB);
        PG8_WAIT_V(6); PG8_BAR;
    }
    for (;;) {
        const bool has_next = S.next(ui + 1, nxt);
        const char* nA = has_next ? (const char*)g.A + (size_t)nxt.pm * tstepA : cA; const char* nB = has_next ? (const char*)g.Bt + (size_t)nxt.pn * tstep : cB;
        for (int t = 0; t < nt; t += 2) {
            const bool last = (t == nt - 2);
            const char* a1 = cA + (size_t)(t + 1) * kstep;
            const char* a2 = last ? nA : cA + (size_t)(t + 2) * kstep; const char* b2 = last ? nB : cB + (size_t)(t + 2) * kstep;
            const char* a3 = a2 + kstep; const char* b3 = b2 + kstep;
            if (last && has_next) S.a_ready(nxt);
            if constexpr (SP2) {
            PG8_LDB(B0, 0, 0); PG8_LDB(B1, 0, 1); PG8_SCHED; PG8_LDA(At, 0, 0); PG8_STAGE(PG8_SA(1, 1), a1 + hstepA, voffA);
            PG8_WAIT_V(8); PG8_WAIT_L(0); PG8_BAR; PG8_MMA(0, 0, At, B0); PG8_MMA(0, 1, At, B1); PG8_BAR; PG8_SCHED;
            PG8_LDA(At, 0, 1); PG8_STAGE(PG8_SB(0, 0), b2, voffB); PG8_STAGE(PG8_SB(0, 1), b2 + hstep, voffB); PG8_STAGE(PG8_SA(0, 0), a2, voffA);
            PG8_WAIT_V(8); PG8_WAIT_L(0); PG8_BAR; PG8_MMA(1, 0, At, B0); PG8_MMA(1, 1, At, B1); PG8_BAR; PG8_SCHED;
            PG8_LDB(B0, 1, 0); PG8_LDB(B1, 1, 1); PG8_SCHED; PG8_LDA(At, 1, 0); PG8_STAGE(PG8_SA(0, 1), a2 + hstepA, voffA);
            PG8_WAIT_V(8); PG8_WAIT_L(0); PG8_BAR; PG8_MMA(0, 0, At, B0); PG8_MMA(0, 1, At, B1); PG8_BAR; PG8_SCHED;
            PG8_LDA(At, 1, 1); PG8_STAGE(PG8_SB(1, 0), b3, voffB); PG8_STAGE(PG8_SB(1, 1), b3 + hstep, voffB); PG8_STAGE(PG8_SA(1, 0), a3, voffA);
            PG8_WAIT_V(8); PG8_WAIT_L(0); PG8_BAR; PG8_MMA(1, 0, At, B0); PG8_MMA(1, 1, At, B1); PG8_BAR; PG8_SCHED;
            } else {
            PG8_LDB(B0, 0, 0); PG8_SCHED; PG8_LDA(At, 0, 0); PG8_STAGE(PG8_SA(1, 1), a1 + hstepA, voffA);
            PG8_WAIT_L(8); PG8_BAR; PG8_WAIT_L(0); PG8_MMA(0, 0, At, B0); PG8_BAR; PG8_SCHED;
            PG8_LDB(B1, 0, 1); PG8_STAGE(PG8_SB(0, 0), b2, voffB);
            PG8_BAR; PG8_WAIT_L(0); PG8_MMA(0, 1, At, B1); PG8_BAR;
            PG8_LDA(At, 0, 1); PG8_STAGE(PG8_SA(0, 0), a2, voffA);
            PG8_BAR; PG8_WAIT_L(0); PG8_MMA(1, 0, At, B0); PG8_BAR; PG8_SCHED;
            PG8_STAGE(PG8_SB(0, 1), b2 + hstep, voffB);
            PG8_WAIT_V(6); PG8_BAR; PG8_MMA(1, 1, At, B1); PG8_BAR;
            PG8_LDB(B0, 1, 0); PG8_SCHED; PG8_LDA(At, 1, 0); PG8_STAGE(PG8_SA(0, 1), a2 + hstepA, voffA);
            PG8_WAIT_L(8); PG8_BAR; PG8_WAIT_L(0); PG8_MMA(0, 0, At, B0); PG8_BAR; PG8_SCHED;
            PG8_LDB(B1, 1, 1); PG8_STAGE(PG8_SB(1, 0), b3, voffB);
            PG8_BAR; PG8_WAIT_L(0); PG8_MMA(0, 1, At, B1); PG8_BAR;
            PG8_LDA(At, 1, 1); PG8_STAGE(PG8_SA(1, 0), a3, voffA);
            PG8_BAR; PG8_WAIT_L(0); PG8_MMA(1, 0, At, B0); PG8_BAR; PG8_SCHED;
            PG8_STAGE(PG8_SB(1, 1), b3 + hstep, voffB);
            PG8_WAIT_V(6); PG8_BAR; PG8_MMA(1, 1, At, B1); PG8_BAR;
            }
        }
        if constexpr (ALIGN_EPI) { if (wr == 0) PG8_BAR; }
        if constexpr (!Epi::AFTER_DRAIN) { int fr_e = fr, fq_e = fq; asm volatile("" : "+v"(fr_e), "+v"(fq_e));   E(acc, cur, wr, wc, fr_e, fq_e); S.done(cur); }
        if (!has_next) break;
#pragma unroll
        for (int a = 0; a < 2; ++a)
#pragma unroll
            for (int b = 0; b < 2; ++b)
#pragma unroll
                for (int m = 0; m < 4; ++m)
#pragma unroll
                    for (int n = 0; n < 2; ++n) acc[a][b][m][n] = (f32x4){0.f, 0.f, 0.f, 0.f};
        cur = nxt; cA = nA; cB = nB; ++ui;
        if constexpr (ALIGN_EPI) { if (wr == 1) PG8_BAR; }
    }
    PG8_WAIT_V(0);
    if constexpr (!ALIGN_EPI) { if (wr == 0) PG8_BAR; }
    PG8_BAR;
    if constexpr (Epi::AFTER_DRAIN) { E.fused(acc, cur, wr, wc, fr, fq, lds, wid, lane); S.done(cur); }
#undef PG8_SA
#undef PG8_SB
#undef PG8_STAGE
#undef PG8_LDA
#undef PG8_LDB
#undef PG8_MMA
#undef PG8_WAIT_V
#undef PG8_WAIT_L
#undef PG8_BAR
#undef PG8_SCHED
}
}
__device__ __forceinline__ double dexp_(double x) {
    const double k = __builtin_rint(x * 1.4426950408889634);
    const double r = (x - k * 0.693147180369123816490e+00) - k * 1.90821492927058770002e-10;
    double t = 1.0 / 6227020800.0;
    t = t * r + 1.0 / 479001600.0; t = t * r + 1.0 / 39916800.0; t = t * r + 1.0 / 3628800.0; t = t * r + 1.0 / 362880.0; t = t * r + 1.0 / 40320.0;
    t = t * r + 1.0 / 5040.0; t = t * r + 1.0 / 720.0; t = t * r + 1.0 / 120.0; t = t * r + 1.0 / 24.0; t = t * r + 1.0 / 6.0; t = t * r + 0.5; t = t * r + 1.0; t = t * r + 1.0;
    const long long bits = (long long)(1023 + (int)k) << 52;
    return t * __builtin_bit_cast(double, bits);
}
__device__ __forceinline__ void dsincos_(double th, double& s, double& c) {
    const double k = __builtin_rint(th * 0.63661977236758134308);
    const double r = (th - k * 1.57079632673412561417e+00) - k * 6.07710050650619224932e-11;
    const double r2 = r * r;
    double ps = -1.0 / 1307674368000.0; ps = ps * r2 + 1.0 / 6227020800.0; ps = ps * r2 - 1.0 / 39916800.0; ps = ps * r2 + 1.0 / 362880.0; ps = ps * r2 - 1.0 / 5040.0; ps = ps * r2 + 1.0 / 120.0; ps = ps * r2 - 1.0 / 6.0; ps = ps * r2 + 1.0;
    const double sr = ps * r;
    double pc = 1.0 / 20922789888000.0; pc = pc * r2 - 1.0 / 87178291200.0; pc = pc * r2 + 1.0 / 479001600.0; pc = pc * r2 - 1.0 / 3628800.0; pc = pc * r2 + 1.0 / 40320.0; pc = pc * r2 - 1.0 / 720.0; pc = pc * r2 + 1.0 / 24.0; pc = pc * r2 - 0.5; pc = pc * r2 + 1.0;
    const int q = ((int)k) & 3;
    s = (q == 0) ? sr : (q == 1) ? pc : (q == 2) ? -sr : -pc;
    c = (q == 0) ? pc : (q == 1) ? -sr : (q == 2) ? -pc : sr;
}
__device__ __forceinline__ int win_dest_row(int n) {
    if (n < 512) return n;
    if (n < 1024) { const int c = n - 512; return 512 + (c >> 7) * 256 + (c & 127); }
    const int c = n - 1024; return 512 + (c >> 7) * 256 + 128 + (c & 127);
}
__device__ __forceinline__ void p0_transpose_item(const float* W, int K, int N, bf16* WT, bool perm_win, LAS float* scr, int item, int lane) {
    const int nblk = N / 32, kb = item / nblk, nb = item % nblk, k0 = 64 * kb, n0 = 32 * nb;
    const int r0 = perm_win ? win_dest_row(n0) : n0;
#pragma unroll 8
    for (int i = 0; i < 32; ++i) { const int kk = 2 * i + (lane >> 5); scr[kk * 33 + (lane & 31)] = W[(size_t)(k0 + kk) * N + n0 + (lane & 31)]; }
    LDS_WAIT();
    const int c = lane & 7;
#pragma unroll
    for (int j = 0; j < 4; ++j) { const int n = (lane >> 3) + 8 * j; const LAS float* s = scr + (8 * c) * 33 + n;
        v4u o; o.x = pk2(s[0 * 33], s[1 * 33]); o.y = pk2(s[2 * 33], s[3 * 33]); o.z = pk2(s[4 * 33], s[5 * 33]); o.w = pk2(s[6 * 33], s[7 * 33]);
        *(v4u*)(WT + (size_t)(r0 + n) * K + k0 + 8 * c) = o; }
    LDS_WAIT();
}

__device__ __forceinline__ void phase0(const Params& p, LAS unsigned char* lds, int tid, int lane, int wave, int blk, int G) {
    float* mod = (float*)(p.ws + WS_MOD); float* modc = (float*)(p.ws + WS_MODC);
    LAS float* sl = (LAS float*)lds;
    LAS float* scr = (LAS float*)(lds + 57344 + wave * 9216);
    if (blk < 96) {
        for (int e = tid; e < 9 * 1024; e += 512) { const float v = e < 8192 ? p.c[e] : p.c_ctx[e - 8192]; sl[e] = v / (1.0f + expf(-v)); }
        __syncthreads();
        const int n = blk * 64 + lane;
        float acc[9];
#pragma unroll
        for (int j = 0; j < 9; ++j) acc[j] = 0.f;
#pragma unroll 4
        for (int k = wave * 128; k < wave * 128 + 128; k += 4) {
            const float w0 = p.ada_w[(size_t)(k + 0) * 6144 + n], w1 = p.ada_w[(size_t)(k + 1) * 6144 + n], w2 = p.ada_w[(size_t)(k + 2) * 6144 + n], w3 = p.ada_w[(size_t)(k + 3) * 6144 + n];
#pragma unroll
            for (int j = 0; j < 9; ++j) { const f32x4 sv = *(const LAS f32x4*)(sl + j * 1024 + k); acc[j] += (sv[0] * w0 + sv[1] * w1) + (sv[2] * w2 + sv[3] * w3); }
        }
        LAS float* red = (LAS float*)(lds + 36864);
#pragma unroll
        for (int j = 0; j < 9; ++j) red[(wave * 9 + j) * 64 + lane] = acc[j];
        __syncthreads();
        for (int e = tid; e < 9 * 64; e += 512) { const int j = e >> 6, l = e & 63; float sum = 0.f;
#pragma unroll
            for (int w = 0; w < 8; ++w) sum += red[(w * 9 + j) * 64 + l];
            const int nn = blk * 64 + l; const float bb = p.ada_b[nn];
            if (j < 8) mod[(size_t)j * 6144 + nn] = sum + bb; else if (nn < 2048) modc[nn] = sum + bb; }
    } else if (blk < 224) {
        const int q = blk - 96, g = q >> 2, dir = (q >> 1) & 1, th = q & 1, dg = dir * 32 + g;
        LAS f32x2* lAp = (LAS f32x2*)lds;
        LAS f32x2* lBb = lAp + 64 * 17;
        LAS f32x2* lC = lBb + 64 * 16;
        f32x2* APOW = (f32x2*)(p.ws + WS_APOW); f32x2* BB = (f32x2*)(p.ws + WS_BB); float* KT = (float*)(p.ws + WS_KT);
        if (tid < 64) {
            const int pp = tid, e = dg * 64 + pp;
            const double lr = (double)p.lam_re[e], li = (double)p.lam_im[e], dt = dexp_((double)p.log_dt[dg]);
            double ar1 = 1.0, ai1 = 0.0;
            for (int n = 0; n <= 16; ++n) { double sn, cs; dsincos_(li * dt * (double)n, sn, cs); const double mag = dexp_(lr * dt * (double)n);
                const f32x2 ap = (f32x2){(float)(mag * cs), (float)(mag * sn)}; lAp[pp * 17 + n] = ap; if (th == 0) APOW[(size_t)e * 17 + n] = ap;
                if (n == 1) { ar1 = mag * cs; ai1 = mag * sn; } }
            const double den = lr * lr + li * li, nr = ar1 - 1.0;
            const double fr = (nr * lr + ai1 * li) / den, fi = (ai1 * lr - nr * li) / den;
#pragma unroll 4
            for (int h = 0; h < 16; ++h) { const double br = (double)p.b_re[(size_t)e * 16 + h], bi = (double)p.b_im[(size_t)e * 16 + h];
                const f32x2 bb = (f32x2){(float)(fr * br - fi * bi), (float)(fr * bi + fi * br)}; lBb[pp * 16 + h] = bb; if (th == 0) BB[(size_t)e * 16 + h] = bb; }
        }
        for (int e = tid; e < 16 * 64; e += 512) { const int i = e >> 6, pp = e & 63; const size_t idx = (size_t)(dg * 16 + i) * 64 + pp; lC[e] = (f32x2){p.c_re[idx], p.c_im[idx]}; }
        __syncthreads();
        for (int e = tid; e < 8 * 256; e += 512) { const int tau = th * 8 + (e >> 8), i = (e >> 4) & 15, j = e & 15; float acc = 0.f;
#pragma unroll 4
            for (int pp = 0; pp < 64; ++pp) { const f32x2 C = lC[i * 64 + pp], A = lAp[pp * 17 + tau], B = lBb[pp * 16 + j];
                const float car = C[0] * A[0] - C[1] * A[1], cai = C[0] * A[1] + C[1] * A[0]; acc += car * B[0] - cai * B[1]; }
            KT[(size_t)(dg * 16 + tau) * 256 + i * 16 + j] = acc; }
    }
    const int gw = blk * 8 + wave, NGW = G * 8;
    constexpr int I_IN = 16 * 48, I_GLU = 8 * 16, I_OUT = 16 * 32, I_1 = 16 * 128, I_2 = 64 * 32, NIT = I_IN + I_GLU + I_OUT + I_1 + I_2;
    for (int it = gw; it < NIT; it += NGW) {
        int r = it;
        if (r < I_IN) { p0_transpose_item(p.w_in, 1024, 1536, (bf16*)(p.ws + WS_WIN), true, scr, r, lane); continue; } r -= I_IN;
        if (r < I_GLU) { p0_transpose_item(p.w_glu, 512, 512, (bf16*)(p.ws + WS_WGLU), false, scr, r, lane); continue; } r -= I_GLU;
        if (r < I_OUT) { p0_transpose_item(p.w_out, 1024, 1024, (bf16*)(p.ws + WS_WOUT), false, scr, r, lane); continue; } r -= I_OUT;
        if (r < I_1) { p0_transpose_item(p.w1, 1024, 4096, (bf16*)(p.ws + WS_W1), false, scr, r, lane); continue; } r -= I_1;
        p0_transpose_item(p.w2, 4096, 1024, (bf16*)(p.ws + WS_W2), false, scr, r, lane);
    }
}

__device__ __forceinline__ void phase1(const Params& p, LAS unsigned char* lds, int tid, int lane, int wave, int blk, int G) {
    const float* mod = (const float*)(p.ws + WS_MOD); const float* modc = (const float*)(p.ws + WS_MODC);
    if (blk < 64) {
        const int n = blk * 64 + lane; float acc[8];
#pragma unroll
        for (int b = 0; b < 8; ++b) acc[b] = 0.f;
        for (int k = wave * 128; k < wave * 128 + 128; ++k) { const float w = p.w1[(size_t)k * DFF + n];
#pragma unroll
            for (int b = 0; b < 8; ++b) acc[b] += mod[(size_t)b * 6144 + 3072 + k] * w; }
        LAS float* red = (LAS float*)lds;
#pragma unroll
        for (int b = 0; b < 8; ++b) red[(wave * 8 + b) * 64 + lane] = acc[b];
        __syncthreads();
        { const int b = tid >> 6; float s = 0.f;
#pragma unroll
          for (int w = 0; w < 8; ++w) s += red[(w * 8 + b) * 64 + lane];
          ((float*)(p.ws + WS_BIAS1))[(size_t)b * DFF + blk * 64 + lane] = s; }
    }
    bf16* A1 = (bf16*)(p.ws + WS_A1);
    const int gw = blk * 8 + wave, NGW = G * 8;
    for (int m = gw; m < MT; m += NGW) {
        const float* xr; const float* sh; const float* sc;
        if (m < ML) { xr = p.x + (size_t)m * DM; sh = mod + (size_t)(m >> 12) * 6144; sc = sh + 1024; }
        else { xr = p.ctx + (size_t)(m - ML) * DM; sh = modc; sc = modc + 1024; }
        f32x4 v[4]; float ss = 0.f;
#pragma unroll
        for (int j = 0; j < 4; ++j) { v[j] = *(const f32x4*)(xr + 4 * lane + 256 * j); ss += (v[j][0] * v[j][0] + v[j][1] * v[j][1]) + (v[j][2] * v[j][2] + v[j][3] * v[j][3]); }
        const float rstd = rsqrtf(wave_sum(ss) * (1.0f / DM) + EPS_RMS);
#pragma unroll
        for (int j = 0; j < 4; ++j) { const int c = 4 * lane + 256 * j;
            const f32x4 g = *(const f32x4*)(p.norm1_g + c), s1 = *(const f32x4*)(sc + c), s0 = *(const f32x4*)(sh + c);
            const f32x4 o = v[j] * rstd * g * (s1 + 1.0f) + s0;
            v2u w; w.x = pk2(o[0], o[1]); w.y = pk2(o[2], o[3]);
            *(v2u*)(A1 + (size_t)m * DM + c) = w; }
    }
}

__device__ __forceinline__ void s5_tables(const Params& p, int tid, int blk, int G) {
    const f32x2* APOW = (const f32x2*)(p.ws + WS_APOW); const f32x2* BB = (const f32x2*)(p.ws + WS_BB); const float* KT = (const float*)(p.ws + WS_KT);
    bf16* WT = (bf16*)(p.ws + WS_WT); bf16* MET = (bf16*)(p.ws + WS_MET);
    for (int it = blk * 512 + tid; it < 262144 + 524288; it += G * 512) {
        float v[8];
        if (it < 262144) {
            const int g = it >> 13, n = (it >> 5) & 255, k0 = (it & 31) * 8, dir = n >> 7, part = (n >> 6) & 1, pp = n & 63, s = k0 >> 4, j0 = k0 & 15;
            const int e = dir ? s : 15 - s; const size_t sp = (size_t)(dir * 32 + g) * 64 + pp;
            const f32x2 A = APOW[sp * 17 + e];
#pragma unroll
            for (int jj = 0; jj < 8; ++jj) { const f32x2 B = BB[sp * 16 + j0 + jj]; v[jj] = part ? (A[0] * B[1] + A[1] * B[0]) : (A[0] * B[0] - A[1] * B[1]); }
            v4u o; o.x = pk2(v[0], v[1]); o.y = pk2(v[2], v[3]); o.z = pk2(v[4], v[5]); o.w = pk2(v[6], v[7]);
            *(v4u*)(WT + ((size_t)(g * 256 + n)) * 256 + k0) = o;
        } else {
            const int it2 = it - 262144, g = it2 >> 14, o_ = (it2 >> 6) & 255, k0 = (it2 & 63) * 8, tl = o_ >> 4, i = o_ & 15;
            if (k0 < 256) {
                const int s = k0 >> 4, j0 = k0 & 15;
#pragma unroll
                for (int jj = 0; jj < 8; ++jj) { const int j = j0 + jj; float a = 0.f;
                    if (s <= tl) a += KT[(size_t)((0 * 32 + g) * 16 + (tl - s)) * 256 + i * 16 + j];
                    if (s >= tl) a += KT[(size_t)((1 * 32 + g) * 16 + (s - tl)) * 256 + i * 16 + j];
                    if (s == tl && i == j) a += p.s5_d[g * 16 + i];
                    v[jj] = a; }
            } else {
                const int kk = k0 - 256, dir = kk >> 7, part = (kk >> 6) & 1, p0 = kk & 63, e = dir ? 16 - tl : tl + 1;
#pragma unroll
                for (int jj = 0; jj < 8; ++jj) { const int pp = p0 + jj; const size_t ci = (size_t)((dir * 32 + g) * 16 + i) * 64 + pp;
                    const float cr = p.c_re[ci], cim = p.c_im[ci]; const f32x2 A = APOW[((size_t)(dir * 32 + g) * 64 + pp) * 17 + e];
                    v[jj] = part ? -(cr * A[1] + cim * A[0]) : (cr * A[0] - cim * A[1]); }
            }
            v4u o; o.x = pk2(v[0], v[1]); o.y = pk2(v[2], v[3]); o.z = pk2(v[4], v[5]); o.w = pk2(v[6], v[7]);
            *(v4u*)(MET + ((size_t)(g * 256 + o_)) * 512 + k0) = o;
        }
    }
}

__device__ __forceinline__ void s5_scan_item(const Params& p, LAS unsigned char* lds, int item, int tid, int lane, int wave) {
    const int g = item & 31;
    const bf16* XC = (const bf16*)(p.ws + WS_XC) + (size_t)item * 16 * 256;
    const bf16* WT = (const bf16*)(p.ws + WS_WT) + (size_t)g * 256 * 256;
    const f32x2* APOW = (const f32x2*)(p.ws + WS_APOW);
    LAS float* Sc = (LAS float*)lds;
    LAS f32x2* Tseg = (LAS f32x2*)(lds + 16384);
    LAS f32x2* H0 = Tseg + 512;
    {
        f32x4 acc0 = (f32x4){0.f, 0.f, 0.f, 0.f}, acc1 = acc0; const int r = lane & 15, kg = lane >> 4;
#pragma unroll
        for (int ks = 0; ks < 8; ++ks) { const pg8::bf16x8 a = *(const pg8::bf16x8*)(XC + r * 256 + ks * 32 + kg * 8);
            const pg8::bf16x8 b0 = *(const pg8::bf16x8*)(WT + (size_t)((2 * wave) * 16 + r) * 256 + ks * 32 + kg * 8), b1 = *(const pg8::bf16x8*)(WT + (size_t)((2 * wave + 1) * 16 + r) * 256 + ks * 32 + kg * 8);
            acc0 = __builtin_amdgcn_mfma_f32_16x16x32_bf16(a, b0, acc0, 0, 0, 0); acc1 = __builtin_amdgcn_mfma_f32_16x16x32_bf16(a, b1, acc1, 0, 0, 0); }
#pragma unroll
        for (int j = 0; j < 4; ++j) { Sc[(kg * 4 + j) * 256 + (2 * wave) * 16 + r] = acc0[j]; Sc[(kg * 4 + j) * 256 + (2 * wave + 1) * 16 + r] = acc1[j]; }
    }
    __syncthreads();
    const int sp = tid & 127, dir = sp >> 6, pp = sp & 63, seg = tid >> 7;
    const f32x2 a16 = APOW[((size_t)(dir * 32 + g) * 64 + pp) * 17 + 16];
    const int c0 = dir ? 255 - seg * 64 : seg * 64, cstep = dir ? -1 : 1;
    const float* Sp = (const float*)(p.ws + WS_S) + (size_t)item * 65536 + (size_t)c0 * 256 + dir * 128 + pp;
    float sr[64], si[64];
#pragma unroll
    for (int q = 0; q < 64; ++q) { sr[q] = Sp[q * cstep * 256]; si[q] = Sp[q * cstep * 256 + 64]; }
    {
        float hr = 0.f, hi = 0.f;
#pragma unroll
        for (int q = 0; q < 64; ++q) { const float nr = a16[0] * hr - a16[1] * hi + sr[q], ni = a16[0] * hi + a16[1] * hr + si[q]; hr = nr; hi = ni; }
        Tseg[seg * 128 + sp] = (f32x2){hr, hi};
        if (seg == 0) { float cr = 0.f, ci = 0.f;
#pragma unroll 4
            for (int q = 0; q < 16; ++q) { const int cc = dir ? 15 - q : q; const float xr = Sc[cc * 256 + dir * 128 + pp], xi = Sc[cc * 256 + dir * 128 + 64 + pp];
                const float nr = a16[0] * cr - a16[1] * ci + xr, ni = a16[0] * ci + a16[1] * cr + xi; cr = nr; ci = ni; }
            H0[sp] = (f32x2){cr, ci}; }
    }
    __syncthreads();
    {
        f32x2 a64 = a16;
#pragma unroll
        for (int i = 0; i < 6; ++i) a64 = (f32x2){a64[0] * a64[0] - a64[1] * a64[1], 2.f * a64[0] * a64[1]};
        f32x2 h = H0[sp];
        for (int s2 = 0; s2 < seg; ++s2) { const f32x2 T = Tseg[s2 * 128 + sp]; h = (f32x2){a64[0] * h[0] - a64[1] * h[1] + T[0], a64[0] * h[1] + a64[1] * h[0] + T[1]}; }
        bf16* Xh = (bf16*)(p.ws + WS_X) + (size_t)item * 256 * 512 + (size_t)c0 * 512 + 256 + dir * 128 + pp;
        float hr = h[0], hi = h[1];
#pragma unroll
        for (int q = 0; q < 64; ++q) {
            Xh[q * cstep * 512] = (bf16)f2bf(hr); Xh[q * cstep * 512 + 64] = (bf16)f2bf(hi);
            const float nr = a16[0] * hr - a16[1] * hi + sr[q], ni = a16[0] * hi + a16[1] * hr + si[q]; hr = nr; hi = ni; }
    }
    asm volatile("s_waitcnt vmcnt(0)" ::: "memory");
    __syncthreads();
}

__device__ __forceinline__ void conv_item(const Params& p, const LAS float* cw, int item, int lane) {
    const bf16* HC = (const bf16*)(p.ws + WS_HC); bf16* YC = (bf16*)(p.ws + WS_YC);
    const int rb = item & 7, w = (item >> 3) & 63, b = item >> 9;
    float acc[8][8];
#pragma unroll
    for (int i = 0; i < 8; ++i)
#pragma unroll
        for (int j = 0; j < 8; ++j) acc[i][j] = 0.f;
    const size_t base = ((size_t)b * SEQ + w) * 512 + lane * 8;
#pragma unroll 1
    for (int d = -15; d <= 22; ++d) {
        const int rin = rb * 8 + d;
        if (rin >= 0 && rin < 64) {
            const v4u hv = *(const v4u*)(HC + base + (size_t)rin * 64 * 512);
            const float h[8] = {bflo(hv.x), bfhi(hv.x), bflo(hv.y), bfhi(hv.y), bflo(hv.z), bfhi(hv.z), bflo(hv.w), bfhi(hv.w)};
            const LAS float* wp = cw + (d + 22) * 512 + lane * 8;
#pragma unroll
            for (int ro = 0; ro < 8; ++ro) { const f32x4 w0 = *(const LAS f32x4*)(wp - ro * 512), w1 = *(const LAS f32x4*)(wp - ro * 512 + 4);
#pragma unroll
                for (int j = 0; j < 4; ++j) { acc[ro][j] += h[j] * w0[j]; acc[ro][4 + j] += h[4 + j] * w1[j]; } }
        }
    }
    const f32x4 cb0 = *(const f32x4*)(p.conv_b + lane * 8), cb1 = *(const f32x4*)(p.conv_b + lane * 8 + 4);
    const f32x4 lg0 = *(const f32x4*)(p.ln_g + lane * 8), lg1 = *(const f32x4*)(p.ln_g + lane * 8 + 4);
    const f32x4 lb0 = *(const f32x4*)(p.ln_b + lane * 8), lb1 = *(const f32x4*)(p.ln_b + lane * 8 + 4);
#pragma unroll
    for (int ro = 0; ro < 8; ++ro) {
        float v[8]; float s = 0.f;
#pragma unroll
        for (int j = 0; j < 4; ++j) { v[j] = acc[ro][j] + cb0[j]; v[4 + j] = acc[ro][4 + j] + cb1[j]; }
#pragma unroll
        for (int j = 0; j < 8; ++j) s += v[j];
        const float mean = wave_sum(s) * (1.0f / 512.0f); float qq = 0.f;
#pragma unroll
        for (int j = 0; j < 8; ++j) { v[j] -= mean; qq += v[j] * v[j]; }
        const float rstd = rsqrtf(wave_sum(qq) * (1.0f / 512.0f) + EPS_LN);
        float o[8];
#pragma unroll
        for (int j = 0; j < 4; ++j) { const float y0 = v[j] * rstd * lg0[j] + lb0[j], y1 = v[4 + j] * rstd * lg1[j] + lb1[j]; o[j] = y0 * sigmoidf_(y0); o[4 + j] = y1 * sigmoidf_(y1); }
        v4u ov; ov.x = pk2(o[0], o[1]); ov.y = pk2(o[2], o[3]); ov.z = pk2(o[4], o[5]); ov.w = pk2(o[6], o[7]);
        *(v4u*)(YC + ((size_t)b * SEQ + (rb * 8 + ro) * 64 + w) * 1024 + 512 + lane * 8) = ov;
    }
}

__device__ __forceinline__ void phase_conv(const Params& p, LAS unsigned char* lds, int tid, int lane, int wave, int blk, int G) {
    LAS float* cw = (LAS float*)lds;
    for (int e = tid; e < 45 * 512; e += 512) { const int kk = e >> 9; cw[e] = (kk >= 7 && kk <= 37) ? p.conv_w[e - 7 * 512] : 0.f; }
    __syncthreads();
    for (int item = blk * 8 + wave; item < 4096; item += G * 8) conv_item(p, cw, item, lane);
}
__device__ __forceinline__ void phase_final(const Params& p, int lane, int wave, int blk, int G) {
    const int gw = blk * 8 + wave, NGW = G * 8;
    for (int m = gw; m < ML; m += NGW) {
        float* o = p.out + (size_t)m * DM; f32x4 v[4]; float ss = 0.f;
#pragma unroll
        for (int j = 0; j < 4; ++j) { v[j] = *(const f32x4*)(o + 4 * lane + 256 * j); ss += (v[j][0] * v[j][0] + v[j][1] * v[j][1]) + (v[j][2] * v[j][2] + v[j][3] * v[j][3]); }
        const float rstd = rsqrtf(wave_sum(ss) * (1.0f / DM) + EPS_RMS);
#pragma unroll
        for (int j = 0; j < 4; ++j) { const f32x4 g = *(const f32x4*)(p.final_g + 4 * lane + 256 * j); *(f32x4*)(o + 4 * lane + 256 * j) = v[j] * rstd * g; }
    }
}

#ifndef REP_P0
#define REP_P0 1
#endif
#ifndef REP_P1
#define REP_P1 1
#endif
#ifndef REP_G1
#define REP_G1 1
#endif
#ifndef REP_S5A
#define REP_S5A 1
#endif
#ifndef REP_CONV
#define REP_CONV 1
#endif
#ifndef REP_S5C
#define REP_S5C 1
#endif
#ifndef REP_GLU
#define REP_GLU 1
#endif
#ifndef REP_OUT
#define REP_OUT 1
#endif
#ifndef REP_UP
#define REP_UP 1
#endif
#ifndef REP_DOWN
#define REP_DOWN 1
#endif
#ifndef NSYNC_EXTRA
#define NSYNC_EXTRA 0
#endif
__global__ void __launch_bounds__(512, 2) fwd_kernel(Params p) {
    extern __shared__ __attribute__((aligned(16))) unsigned char lds_raw[];
    cg::grid_group grid = cg::this_grid();
    LAS unsigned char* lds = (LAS unsigned char*)lds_raw;
    const int blk = blockIdx.x, G = gridDim.x;
#define TIDX ((int)threadIdx.x)
#define TL int t_ = TIDX; asm volatile("" : "+v"(t_)); const int tid = t_, lane = t_ & 63, wave = __builtin_amdgcn_readfirstlane(t_ >> 6); (void)tid; (void)lane; (void)wave;
    unsigned char* ws = p.ws;
    if (threadIdx.x < 2) ((volatile LAS unsigned*)(lds + LDS_MISC))[threadIdx.x] = 0u;
    if (blk == 0) for (int e = threadIdx.x; e < XCD_BAR_WORDS; e += 512) ((unsigned*)(ws + WS_BAR))[e] = 0u;
    __syncthreads();

    for (int rep = 0; rep < REP_P0; ++rep)
    { TL phase0(p, lds, tid, lane, wave, blk, G); }
    grid.sync();
    const XcdBarrier xbar = xcd_barrier_post((unsigned*)(ws + WS_BAR), (volatile LAS unsigned*)(lds + LDS_MISC));
    for (int rep = 0; rep < REP_P1; ++rep) {
    { TL phase1(p, lds, tid, lane, wave, blk, G); }
    }
    for (int rep = 0; rep < NSYNC_EXTRA; ++rep) xcd_barrier(xbar);
    xcd_barrier(xbar);
    for (int rep = 0; rep < REP_G1; ++rep)
    {
        pg8::Gemm g{(const bf16*)(ws + WS_A1), (const bf16*)(ws + WS_WIN), MT, INC, DM, DM}; pg8::G1Order S; S.init(G, blk);
        pg8::EpiG1 E{(bf16*)(ws + WS_X), (bf16*)(ws + WS_XC), (bf16*)(ws + WS_HC)};
        pg8::gemm_phase<pg8::EpiG1, pg8::G1Order, true, true>(lds, g, S, E, TIDX);
        if (blk >= 16 && G > 16) { TL s5_tables(p, tid, blk - 16, G - 16); }
    }
    xcd_barrier(xbar);
    for (int rep = 0; rep < REP_S5A; ++rep)
    {
        pg8::Gemm g{(const bf16*)(ws + WS_X), (const bf16*)(ws + WS_WT), 65536, 256, 256, 512}; pg8::ItemOrder S{G, blk, 256};
        pg8::EpiS5A E{(float*)(ws + WS_S)};
        pg8::gemm_phase<pg8::EpiS5A, pg8::ItemOrder, true, true>(lds, g, S, E, TIDX);
    }
    for (int rep = 0; rep < REP_CONV; ++rep)
    { TL phase_conv(p, lds, tid, lane, wave, blk, G); }
    xcd_barrier(xbar);
    for (int rep = 0; rep < REP_S5C; ++rep)
    for (int item = blk; item < 256; item += G) {
        { TL s5_scan_item(p, lds, item, tid, lane, wave); }
        pg8::Gemm g{(const bf16*)(ws + WS_X), (const bf16*)(ws + WS_MET), 65536, 256, 512, 512}; pg8::OneUnit S{item, item & 31};
        pg8::EpiS5C E{(bf16*)(ws + WS_G)};
        pg8::gemm_phase<pg8::EpiS5C, pg8::OneUnit, true, true>(lds, g, S, E, TIDX);
    }
    xcd_barrier(xbar);
    for (int rep = 0; rep < REP_GLU; ++rep)
    {
        pg8::Gemm g{(const bf16*)(ws + WS_G), (const bf16*)(ws + WS_WGLU), ML, S5W, S5W, S5W}; pg8::StaticOrder S; S.init(ML, S5W, G, blk);
        pg8::EpiGlu E{(const bf16*)(ws + WS_G), (bf16*)(ws + WS_YC)};
        pg8::gemm_phase<pg8::EpiGlu, pg8::StaticOrder, true, true>(lds, g, S, E, TIDX);
    }
    xcd_barrier(xbar);
    for (int rep = 0; rep < REP_OUT; ++rep)
    {
        pg8::Gemm g{(const bf16*)(ws + WS_YC), (const bf16*)(ws + WS_WOUT), ML, DM, DM, DM}; pg8::StaticOrder S; S.init(ML, DM, G, blk);
        pg8::EpiOut E{p.x, (const float*)(ws + WS_MOD), p.norm2_g, (float*)(ws + WS_H1), (bf16*)(ws + WS_HS), (float*)(ws + WS_SS1)};
        pg8::gemm_phase<pg8::EpiOut, pg8::StaticOrder, true, true>(lds, g, S, E, TIDX);
    }
    xcd_barrier(xbar);
    for (int rep = 0; rep < REP_UP; ++rep)
    {
        pg8::Gemm g{(const bf16*)(ws + WS_HS), (const bf16*)(ws + WS_W1), ML, DFF, DM, DM}; pg8::StaticOrder S; S.init(ML, DFF, G, blk);
        pg8::EpiUp E{(const float*)(ws + WS_SS1), (const float*)(ws + WS_BIAS1), (bf16*)(ws + WS_HID)};
        pg8::gemm_phase<pg8::EpiUp, pg8::StaticOrder, true, true>(lds, g, S, E, TIDX);
    }
    xcd_barrier(xbar);
    for (int rep = 0; rep < REP_DOWN; ++rep)
    {
        pg8::Gemm g{(const bf16*)(ws + WS_HID), (const bf16*)(ws + WS_W2), ML, DM, DFF, DFF}; pg8::StaticOrder S; S.init(ML, DM, G, blk);
        pg8::EpiDown E{(const float*)(ws + WS_H1), (const float*)(ws + WS_MOD), p.out};
        pg8::gemm_phase<pg8::EpiDown, pg8::StaticOrder, true, true>(lds, g, S, E, TIDX);
    }
    xcd_barrier(xbar);
    { TL phase_final(p, lane, wave, blk, G); }
}

extern "C" void kernel_launch(void* const* d_in, const int* in_sizes, int n_in, void* d_out, int out_size, void* d_ws, size_t ws_size, hipStream_t stream) {
    static int grid = 0;
    if (grid == 0) {
        if (n_in != 26 || out_size != ML * DM || ws_size < WS_END) { fprintf(stderr, "kernel_launch: unexpected shapes (n_in %d out %d ws %zu)\n", n_in, out_size, ws_size); grid = -1; return; }
        int dev = 0, cus = 0, per_cu = 0;
        hipGetDevice(&dev);
        hipDeviceGetAttribute(&cus, hipDeviceAttributeMultiprocessorCount, dev);
        if (hipFuncSetAttribute((const void*)fwd_kernel, hipFuncAttributeMaxDynamicSharedMemorySize, LDS_BYTES) != hipSuccess) { fprintf(stderr, "kernel_launch: hipFuncSetAttribute failed\n"); grid = -1; return; }
        if (hipOccupancyMaxActiveBlocksPerMultiprocessor(&per_cu, (const void*)fwd_kernel, 512, LDS_BYTES) != hipSuccess || per_cu < 1) { fprintf(stderr, "kernel_launch: occupancy query says %d\n", per_cu); per_cu = 1; (void)hipGetLastError(); }
        grid = cus * per_cu;
    }
    if (grid < 0) return;
    Params p{};
    const float** f = (const float**)&p;
    for (int i = 0; i < 26; ++i) f[i] = (const float*)d_in[i];
    p.out = (float*)d_out; p.ws = (unsigned char*)d_ws;
    void* args[] = {&p};
    hipError_t e = hipLaunchCooperativeKernel((const void*)fwd_kernel, dim3(grid), dim3(512), args, LDS_BYTES, stream);
    if (e != hipSuccess) fprintf(stderr, "cooperative launch failed: %s (grid %d)\n", hipGetErrorString(e), grid);
}
```

```cpp
#include <hip/hip_runtime.h>
#include <hip/hip_cooperative_groups.h>
#include <cstdio>
#include <cstdint>
namespace cg = cooperative_groups;
#define GAS __attribute__((address_space(1)))
#define LAS __attribute__((address_space(3)))
typedef unsigned short bf16;
typedef unsigned v4u __attribute__((ext_vector_type(4)));
typedef unsigned v2u __attribute__((ext_vector_type(2)));
typedef float f32x4 __attribute__((ext_vector_type(4)));
typedef float f32x2 __attribute__((ext_vector_type(2)));
constexpr int DM = 1024, NB = 8, SEQ = 4096, NCTX = 256, ML = NB * SEQ, MC = NB * NCTX, MT = ML + MC;
constexpr int S5W = 512, CVW = 512, INC = 1536, DFF = 4096, NG = 32, NP = 64, NH = 16, CK = 31;
constexpr float EPS_RMS = 1e-6f, EPS_LN = 1e-5f;
constexpr size_t MiB = 1u << 20;
constexpr size_t WS_HID = 0;
constexpr size_t WS_A1 = 0, WS_S = 0;
constexpr size_t WS_X = 68 * MiB;
constexpr size_t WS_XC = 132 * MiB;
constexpr size_t WS_HC = 134 * MiB;
constexpr size_t WS_G = 230 * MiB;
constexpr size_t WS_YC = 166 * MiB;
constexpr size_t WS_H1 = 256 * MiB;
constexpr size_t WS_HS = 384 * MiB;
constexpr size_t WS_WIN = 448 * MiB, WS_WGLU = 451 * MiB, WS_WOUT = 452 * MiB, WS_W1 = 454 * MiB, WS_W2 = 462 * MiB;
constexpr size_t WS_MOD = 470 * MiB, WS_MODC = WS_MOD + 256 * 1024, WS_BIAS1 = WS_MOD + 512 * 1024;
constexpr size_t WS_BAR = WS_MOD + 768 * 1024;
constexpr size_t WS_SS1 = 471 * MiB;
constexpr size_t WS_APOW = 473 * MiB;
constexpr size_t WS_BB = 474 * MiB;
constexpr size_t WS_KT = 475 * MiB;
constexpr size_t WS_WT = 476 * MiB;
constexpr size_t WS_MET = 480 * MiB;
constexpr size_t WS_END = 512 * MiB;
constexpr int LDS_BYTES = 139264;
constexpr int LDS_MISC = 131072 + 256;

struct Params {
    const float *x, *c, *ctx, *c_ctx, *ada_w, *ada_b, *norm1_g, *w_in, *lam_re, *lam_im, *log_dt, *b_re, *b_im, *c_re, *c_im, *s5_d, *w_glu,
                *conv_w, *conv_b, *ln_g, *ln_b, *w_out, *norm2_g, *w1, *w2, *final_g;
    float* out; unsigned char* ws;
};

__device__ __forceinline__ unsigned f2bf(float f) { unsigned u = __builtin_bit_cast(unsigned, f); return (u + 0x7fffu + ((u >> 16) & 1u)) >> 16; }
__device__ __forceinline__ unsigned pk2(float lo, float hi) { return f2bf(lo) | (f2bf(hi) << 16); }
__device__ __forceinline__ float bflo(unsigned w) { return __builtin_bit_cast(float, w << 16); }
__device__ __forceinline__ float bfhi(unsigned w) { return __builtin_bit_cast(float, w & 0xffff0000u); }
__device__ __forceinline__ float wave_sum(float v) {
#pragma unroll
    for (int o = 1; o < 64; o <<= 1) v += __shfl_xor(v, o);
    return v;
}
__device__ __forceinline__ float sigmoidf_(float g) { return __builtin_amdgcn_rcpf(1.0f + __expf(-g)); }
__device__ __forceinline__ float gelu_tanh(float y) {
    const float z = 0.7978845608028654f * (y + 0.044715f * y * y * y);
    const float th = 1.0f - 2.0f * __builtin_amdgcn_rcpf(1.0f + __expf(2.0f * z));
    return 0.5f * y * (1.0f + th);
}
#define LDS_WAIT() asm volatile("s_waitcnt lgkmcnt(0)" ::: "memory")

#define XB_TMO      128
#define XB_XCNT(j)  (256  + 64 * (j))
#define XB_XSUB(j)  (1280 + 64 * (j))
#define XB_XGEN(j)  (2304 + 64 * (j))
#define XB_TOP      3328
#define XB_TOPGEN   3392
#define XCD_BAR_WORDS 3456
#define XB_SPIN_CAP (1u << 18)

__device__ __forceinline__ unsigned xb_ld(unsigned* p)              { return __hip_atomic_load(p, __ATOMIC_RELAXED, __HIP_MEMORY_SCOPE_AGENT); }
__device__ __forceinline__ unsigned xb_add(unsigned* p, unsigned v) { return __hip_atomic_fetch_add(p, v, __ATOMIC_RELAXED, __HIP_MEMORY_SCOPE_AGENT); }
__device__ __forceinline__ unsigned xb_xcc_id() { return (unsigned)__builtin_amdgcn_s_getreg((3 << 11) | 20) & 0xFu; }
#define XB_SPIN(cond, bar) do { unsigned _sp = 0; while (cond) { __builtin_amdgcn_s_sleep(1); \
    if ((++_sp & 255u) == 0u) { if (xb_ld(&(bar)[XB_TMO])) break; if (_sp > XB_SPIN_CAP) { atomicAdd(&(bar)[XB_TMO], 1u); break; } } } } while (0)

struct XcdBarrier {
    unsigned* bar; unsigned x;
    volatile LAS unsigned* st;
};

__device__ __forceinline__ XcdBarrier xcd_barrier_post(unsigned* bar, volatile LAS unsigned* st) {
    XcdBarrier b; b.bar = bar; b.x = xb_xcc_id(); b.st = st;
    if (threadIdx.x == 0) (void)xb_add(&bar[XB_XCNT(b.x)], 1u);
    return b;
}
__device__ __forceinline__ void xcd_barrier_complete(unsigned* bar, unsigned x, unsigned& nloc, unsigned& nx) {
    const unsigned G = gridDim.x * gridDim.y * gridDim.z;
    unsigned sum, cnt, mine, sp = 0u;
    for (;;) {
        sum = 0u; cnt = 0u; mine = 0u;
#pragma unroll
        for (unsigned j = 0; j < 16; ++j) { const unsigned c = xb_ld(&bar[XB_XCNT(j)]); sum += c; cnt += (c > 0u) ? 1u : 0u; mine = (j == x) ? c : mine; }
        if (sum == G) break;
        __builtin_amdgcn_s_sleep(1);
        if ((++sp & 255u) == 0u) { if (xb_ld(&bar[XB_TMO])) break; if (sp > XB_SPIN_CAP) { atomicAdd(&bar[XB_TMO], 1u); break; } }
    }
    nloc = mine > 0u ? mine : 1u; nx = cnt > 0u ? cnt : 1u;
}

__device__ __forceinline__ void xcd_barrier(const XcdBarrier& b) {
    asm volatile("s_waitcnt vmcnt(0)" ::: "memory");
    __syncthreads();
    if (threadIdx.x == 0) {
        unsigned* bar = b.bar;
        __builtin_amdgcn_s_waitcnt(0);
        unsigned nloc = b.st[0], nx = b.st[1];
        if (nloc == 0u) { xcd_barrier_complete(bar, b.x, nloc, nx); b.st[0] = nloc; b.st[1] = nx; }
        const unsigned old = xb_add(&bar[XB_XSUB(b.x)], 1u);
        const unsigned gen = old / nloc;
        if (old + 1u == (gen + 1u) * nloc) {
            __builtin_amdgcn_fence(__ATOMIC_RELEASE, "agent");
            asm volatile("s_waitcnt vmcnt(0)" ::: "memory");
            const unsigned og = xb_add(&bar[XB_TOP], 1u);
            const unsigned tg = og / nx;
            if (og + 1u == (tg + 1u) * nx) xb_add(&bar[XB_TOPGEN], 1u);
            else XB_SPIN(xb_ld(&bar[XB_TOPGEN]) == tg, bar);
            __builtin_amdgcn_fence(__ATOMIC_ACQUIRE, "agent");
            xb_add(&bar[XB_XGEN(b.x)], 1u);
            asm volatile("s_waitcnt vmcnt(0)" ::: "memory");
        } else {
            XB_SPIN(xb_ld(&bar[XB_XGEN(b.x)]) == gen, bar);
            __builtin_amdgcn_fence(__ATOMIC_ACQUIRE, "agent");
            asm volatile("s_waitcnt vmcnt(0)" ::: "memory");
        }
    }
    __syncthreads();
}
namespace pg8 {
#define PG8_LAS __attribute__((address_space(3)))
typedef unsigned short bf16_t;
typedef short bf16x8 __attribute__((ext_vector_type(8)));
typedef float f32x4 __attribute__((ext_vector_type(4)));
typedef unsigned u32x4 __attribute__((ext_vector_type(4)));
constexpr int BM = 256, BK = 64, HALF = 128, HTB = HALF * BK * 2  , STAGE_BYTES = 8 * HTB, NXCD = 8, WGM = 8;

__host__ __device__ __forceinline__ int lds_byte(int r, int c) { const int st = (r >> 4) * 2 + (c >> 5), rr = r & 15, cc = c & 31, ob = rr * 64 + cc * 2; return st * 1024 + (ob ^ (((ob >> 9) & 1) << 5)); }
__host__ __device__ __forceinline__ void stage_rc(int b, int& R, int& C) { const int st = b / 1024, sb = b % 1024, swz = sb ^ (((sb >> 9) & 1) << 5); R = (st >> 1) * 16 + swz / 64; C = (st & 1) * 32 + (swz % 64) / 2; }
__host__ __device__ __forceinline__ int perm32(int rho) { const int n = rho >> 4, i = rho & 15; return 8 * (i >> 2) + 4 * n + (i & 3); }

struct Unit { int pm, pn; };
struct Gemm { const bf16_t* A; const bf16_t* Bt; int M, N, K, lda; };

struct StaticOrder {
    int nM, nN, nwg, G, c;
    __host__ __device__ void init(int M, int N, int G_, int c_) { nM = M / BM; nN = N / BM; nwg = nM * nN; G = G_; c = c_; }
    __host__ __device__ bool next(int i, Unit& u) const {
        const long L = (long)i * G + c; if (L >= nwg) return false;
        int wgid = (int)L; { const int q = nwg / NXCD, r = nwg % NXCD, xcd = wgid % NXCD, off = wgid / NXCD; wgid = (xcd < r ? xcd * (q + 1) : r * (q + 1) + (xcd - r) * q) + off; }
        const int nig = WGM * nN, gid = wgid / nig, fm = gid * WGM, gsz = (nM - fm) < WGM ? (nM - fm) : WGM;
        u.pm = fm + ((wgid % nig) % gsz); u.pn = (wgid % nig) / gsz; return true;
    }
    __device__ __forceinline__ void a_ready(const Unit&) const {}
    __device__ __forceinline__ void done(const Unit&) const {}
};

__device__ __forceinline__ unsigned cvt_pk_bf16(float lo, float hi) { unsigned r; asm volatile("v_cvt_pk_bf16_f32 %0, %1, %2" : "=v"(r) : "v"(lo), "v"(hi)); return r; }
typedef float f32x2 __attribute__((ext_vector_type(2)));
}
namespace pg8 {
typedef unsigned u32x4 __attribute__((ext_vector_type(4)));
typedef unsigned u32x2 __attribute__((ext_vector_type(2)));
struct EpiG1 {
    static constexpr bool PERM = true, AFTER_DRAIN = false;
    bf16_t* X; bf16_t* XC; bf16_t* HC;
    __device__ __forceinline__ void operator()(const f32x4 (&acc)[2][2][4][2], const Unit& u, int wr, int wc, int fr, int fq) const {
        const int row0 = u.pm * BM + wr * 64 + fr;
        if (u.pn < 2) {
            const int col0 = u.pn * BM + wc * 32 + 8 * fq;
#pragma unroll
            for (int ai = 0; ai < 2; ++ai)
#pragma unroll
                for (int m = 0; m < 4; ++m) { const int row = row0 + ai * HALF + m * 16;
#pragma unroll
                    for (int bj = 0; bj < 2; ++bj) { const int col = col0 + bj * HALF, g = col >> 4, j0 = col & 15; bf16_t* dst;
                        if (row < ML) { const int b = row >> 12, c = (row >> 4) & 255, s = row & 15; dst = X + ((size_t)((b * 32 + g) * 256 + c)) * 512 + s * 16 + j0; }
                        else { const int rr = row - ML, b = rr >> 8, c = (rr >> 4) & 15, s = rr & 15; dst = XC + ((size_t)((b * 32 + g) * 16 + c)) * 256 + s * 16 + j0; }
                        const f32x4 v0 = acc[ai][bj][m][0], v1 = acc[ai][bj][m][1]; u32x4 w;
                        w.x = cvt_pk_bf16(v0[0], v0[1]); w.y = cvt_pk_bf16(v0[2], v0[3]); w.z = cvt_pk_bf16(v1[0], v1[1]); w.w = cvt_pk_bf16(v1[2], v1[3]);
                        *(u32x4*)dst = w; } }
        } else {
            const int ch0 = (u.pn - 2) * HALF + wc * 32 + 8 * fq;
#pragma unroll
            for (int ai = 0; ai < 2; ++ai)
#pragma unroll
                for (int m = 0; m < 4; ++m) { bf16_t* rowp = HC + (size_t)(row0 + ai * HALF + m * 16) * 512 + ch0; float h[8];
#pragma unroll
                    for (int n = 0; n < 2; ++n)
#pragma unroll
                        for (int j = 0; j < 4; ++j) h[n * 4 + j] = acc[ai][0][m][n][j] * sigmoidf_(acc[ai][1][m][n][j]);
                    u32x4 w; w.x = cvt_pk_bf16(h[0], h[1]); w.y = cvt_pk_bf16(h[2], h[3]); w.z = cvt_pk_bf16(h[4], h[5]); w.w = cvt_pk_bf16(h[6], h[7]);
                    *(u32x4*)rowp = w; }
        }
    }
};
struct EpiS5A {
    static constexpr bool PERM = false, AFTER_DRAIN = false;
    float* S;
    __device__ __forceinline__ void operator()(const f32x4 (&acc)[2][2][4][2], const Unit& u, int wr, int wc, int fr, int fq) const {
        float* rp = S + ((size_t)u.pm * 256 + wr * 64 + fr) * 256 + wc * 32 + 4 * fq;
#pragma unroll
        for (int ai = 0; ai < 2; ++ai) {
#pragma unroll
            for (int m = 0; m < 4; ++m) {
#pragma unroll
                for (int bj = 0; bj < 2; ++bj)
#pragma unroll
                    for (int n = 0; n < 2; ++n) *(f32x4*)(rp + bj * HALF + n * 16) = acc[ai][bj][m][n];
                rp += 16 * 256; asm volatile("" : "+v"(rp)); }
            rp += 64 * 256; }
    }
};
struct EpiS5C {
    static constexpr bool PERM = true, AFTER_DRAIN = false;
    bf16_t* G;
    __device__ __forceinline__ void operator()(const f32x4 (&acc)[2][2][4][2], const Unit& u, int wr, int wc, int fr, int fq) const {
        const int b = u.pm >> 5, g = u.pm & 31;
#pragma unroll
        for (int ai = 0; ai < 2; ++ai)
#pragma unroll
            for (int m = 0; m < 4; ++m) { const int c = ai * HALF + wr * 64 + m * 16 + fr;
#pragma unroll
                for (int bj = 0; bj < 2; ++bj) { const int o0 = bj * HALF + wc * 32 + 8 * fq, tl = o0 >> 4, i0 = o0 & 15;
                    const f32x4 v0 = acc[ai][bj][m][0], v1 = acc[ai][bj][m][1]; u32x4 w;
                    w.x = cvt_pk_bf16(gelu_tanh(v0[0]), gelu_tanh(v0[1])); w.y = cvt_pk_bf16(gelu_tanh(v0[2]), gelu_tanh(v0[3]));
                    w.z = cvt_pk_bf16(gelu_tanh(v1[0]), gelu_tanh(v1[1])); w.w = cvt_pk_bf16(gelu_tanh(v1[2]), gelu_tanh(v1[3]));
                    *(u32x4*)(G + ((size_t)(b * SEQ + c * 16 + tl)) * 512 + g * 16 + i0) = w; } }
    }
};
struct EpiGlu {
    static constexpr bool PERM = true, AFTER_DRAIN = false;
    const bf16_t* G; bf16_t* YC;
    __device__ __forceinline__ void operator()(const f32x4 (&acc)[2][2][4][2], const Unit& u, int wr, int wc, int fr, int fq) const {
        const int row0 = u.pm * BM + wr * 64 + fr, col0 = u.pn * BM + wc * 32 + 8 * fq;
#pragma unroll
        for (int ai = 0; ai < 2; ++ai)
#pragma unroll
            for (int m = 0; m < 4; ++m) { const size_t row = (size_t)(row0 + ai * HALF + m * 16);
#pragma unroll
                for (int bj = 0; bj < 2; ++bj) { const u32x4 gv = *(const u32x4*)(G + row * 512 + col0 + bj * HALF);
                    const f32x4 v0 = acc[ai][bj][m][0], v1 = acc[ai][bj][m][1]; u32x4 w;
                    w.x = cvt_pk_bf16(bflo(gv.x) * sigmoidf_(v0[0]), bfhi(gv.x) * sigmoidf_(v0[1]));
                    w.y = cvt_pk_bf16(bflo(gv.y) * sigmoidf_(v0[2]), bfhi(gv.y) * sigmoidf_(v0[3]));
                    w.z = cvt_pk_bf16(bflo(gv.z) * sigmoidf_(v1[0]), bfhi(gv.z) * sigmoidf_(v1[1]));
                    w.w = cvt_pk_bf16(bflo(gv.w) * sigmoidf_(v1[2]), bfhi(gv.w) * sigmoidf_(v1[3]));
                    *(u32x4*)(YC + row * 1024 + col0 + bj * HALF) = w; } }
    }
};
struct EpiOut {
    static constexpr bool PERM = false, AFTER_DRAIN = false;
    const float* x; const float* mod; const float* n2g; float* H1; bf16_t* HS; float* SS1;
    __device__ __forceinline__ void operator()(const f32x4 (&acc)[2][2][4][2], const Unit& u, int wr, int wc, int fr, int fq) const {
        const int row0 = u.pm * BM + wr * 64 + fr, col0 = u.pn * BM + wc * 32 + 4 * fq;
        const int b = (u.pm * BM) >> 12;
        const float* mb = mod + (size_t)b * 6144;
        f32x4 g1v[2][2], wsv[2][2];
#pragma unroll
        for (int bj = 0; bj < 2; ++bj)
#pragma unroll
            for (int n = 0; n < 2; ++n) { const int c = col0 + bj * HALF + n * 16;
                g1v[bj][n] = *(const f32x4*)(mb + 2048 + c);
                wsv[bj][n] = *(const f32x4*)(n2g + c) * (*(const f32x4*)(mb + 4096 + c) + 1.0f); }
#pragma unroll
        for (int ai = 0; ai < 2; ++ai)
#pragma unroll
            for (int m = 0; m < 4; ++m) { const int row = row0 + ai * HALF + m * 16; const size_t off = (size_t)row * DM + col0; float ss = 0.f;
#pragma unroll
                for (int bj = 0; bj < 2; ++bj)
#pragma unroll
                    for (int n = 0; n < 2; ++n) { const size_t o = off + bj * HALF + n * 16;
                        const f32x4 h1 = *(const f32x4*)(x + o) + g1v[bj][n] * acc[ai][bj][m][n];
                        *(f32x4*)(H1 + o) = h1; ss += (h1[0] * h1[0] + h1[1] * h1[1]) + (h1[2] * h1[2] + h1[3] * h1[3]);
                        const f32x4 hs = h1 * wsv[bj][n]; u32x2 w; w.x = cvt_pk_bf16(hs[0], hs[1]); w.y = cvt_pk_bf16(hs[2], hs[3]);
                        *(u32x2*)(HS + o) = w; }
                ss += __shfl_xor(ss, 16); ss += __shfl_xor(ss, 32);
                if (fq == 0) SS1[(size_t)row * 16 + u.pn * 4 + wc] = ss; }
    }
};
struct EpiUp {
    static constexpr bool PERM = true, AFTER_DRAIN = false;
    const float* SS1; const float* bias1; bf16_t* HID;
    __device__ __forceinline__ void operator()(const f32x4 (&acc)[2][2][4][2], const Unit& u, int wr, int wc, int fr, int fq) const {
        const int row0 = u.pm * BM + wr * 64 + fr, col0 = u.pn * BM + wc * 32 + 8 * fq;
        const int b = (u.pm * BM) >> 12;
        f32x4 bv[2][2];
#pragma unroll
        for (int bj = 0; bj < 2; ++bj)
#pragma unroll
            for (int n = 0; n < 2; ++n) bv[bj][n] = *(const f32x4*)(bias1 + (size_t)b * DFF + col0 + bj * HALF + 4 * n);
#pragma unroll
        for (int ai = 0; ai < 2; ++ai)
#pragma unroll
            for (int m = 0; m < 4; ++m) { const int row = row0 + ai * HALF + m * 16;
                const f32x4* sp = (const f32x4*)(SS1 + (size_t)row * 16); const f32x4 s0 = sp[0], s1 = sp[1], s2 = sp[2], s3 = sp[3];
                const float ss = ((s0[0] + s0[1]) + (s0[2] + s0[3])) + ((s1[0] + s1[1]) + (s1[2] + s1[3])) + ((s2[0] + s2[1]) + (s2[2] + s2[3])) + ((s3[0] + s3[1]) + (s3[2] + s3[3]));
                const float rstd = rsqrtf(ss * (1.0f / DM) + EPS_RMS);
                bf16_t* rowp = HID + (size_t)row * DFF + col0;
#pragma unroll
                for (int bj = 0; bj < 2; ++bj) { f32x4 v0 = acc[ai][bj][m][0] * rstd + bv[bj][0], v1 = acc[ai][bj][m][1] * rstd + bv[bj][1];
#pragma unroll
                    for (int j = 0; j < 4; ++j) { const float a = fmaxf(v0[j], 0.f), c = fmaxf(v1[j], 0.f); v0[j] = a * a; v1[j] = c * c; }
                    u32x4 w; w.x = cvt_pk_bf16(v0[0], v0[1]); w.y = cvt_pk_bf16(v0[2], v0[3]); w.z = cvt_pk_bf16(v1[0], v1[1]); w.w = cvt_pk_bf16(v1[2], v1[3]);
                    *(u32x4*)(rowp + bj * HALF) = w; } }
    }
};
struct EpiDown {
    static constexpr bool PERM = false, AFTER_DRAIN = false;
    const float* H1; const float* mod; float* out;
    __device__ __forceinline__ void operator()(const f32x4 (&acc)[2][2][4][2], const Unit& u, int wr, int wc, int fr, int fq) const {
        const int row0 = u.pm * BM + wr * 64 + fr, col0 = u.pn * BM + wc * 32 + 4 * fq;
        const int b = (u.pm * BM) >> 12;
        const float* mb = mod + (size_t)b * 6144 + 5120;
        f32x4 g2v[2][2];
#pragma unroll
        for (int bj = 0; bj < 2; ++bj)
#pragma unroll
            for (int n = 0; n < 2; ++n) g2v[bj][n] = *(const f32x4*)(mb + col0 + bj * HALF + n * 16);
#pragma unroll
        for (int ai = 0; ai < 2; ++ai)
#pragma unroll
            for (int m = 0; m < 4; ++m) { const size_t off = (size_t)(row0 + ai * HALF + m * 16) * DM + col0;
#pragma unroll
                for (int bj = 0; bj < 2; ++bj)
#pragma unroll
                    for (int n = 0; n < 2; ++n) { const size_t o = off + bj * HALF + n * 16;
                        *(f32x4*)(out + o) = *(const f32x4*)(H1 + o) + g2v[bj][n] * acc[ai][bj][m][n]; } }
    }
};
struct G1Order {
    StaticOrder so;
    __device__ void init(int G, int c) { so.init(ML, INC, G, c); }
    __device__ bool next(int i, Unit& u) const {
        const long L = (long)i * so.G + so.c;
        if (L < so.nwg) return so.next(i, u);
        const int e = (int)(L - so.nwg); if (e >= 16) return false;
        u.pm = 128 + (e >> 1); u.pn = e & 1; return true;
    }
    __device__ __forceinline__ void a_ready(const Unit&) const {}
    __device__ __forceinline__ void done(const Unit&) const {}
};
struct ItemOrder {
    int G, c, n;
    __device__ bool next(int i, Unit& u) const { const int it = c + i * G; if (it >= n) return false; u.pm = it; u.pn = it & 31; return true; }
    __device__ __forceinline__ void a_ready(const Unit&) const {}
    __device__ __forceinline__ void done(const Unit&) const {}
};
struct OneUnit {
    int pm, pn;
    __device__ bool next(int i, Unit& u) const { if (i) return false; u.pm = pm; u.pn = pn; return true; }
    __device__ __forceinline__ void a_ready(const Unit&) const {}
    __device__ __forceinline__ void done(const Unit&) const {}
};
}
namespace pg8 {
template <class Epi, class Sched, bool ALIGN_EPI = false, bool SP2 = false>
__device__ __forceinline__ void gemm_phase(PG8_LAS unsigned char* lds, const Gemm g, const Sched& S, const Epi& E, int tid_in) {
    int tid_l = tid_in; asm volatile("" : "+v"(tid_l));
    const int tid = tid_l, wid = __builtin_amdgcn_readfirstlane(tid >> 6), lane = tid & 63, wr = wid >> 2, wc = wid & 3, fr = lane & 15, fq = lane >> 4;
    const int K = g.K; int nt_l = K / BK; asm volatile("" : "+s"(nt_l)); const int nt = nt_l;
    unsigned voffA[2], voffB[2];
#pragma unroll
    for (int i = 0; i < 2; ++i) { int R, C; stage_rc(tid * 16 + i * 8192, R, C); const int Rb = Epi::PERM ? ((R & ~31) + perm32(R & 31)) : R;
        voffA[i] = (unsigned)(R * g.lda + C) * 2u; voffB[i] = (unsigned)(Rb * K + C) * 2u; }
    const size_t kstep = (size_t)(BK * 2);
    const size_t hstep = (size_t)HALF * K * 2; const size_t hstepA = (size_t)HALF * g.lda * 2; const size_t tstepA = 2 * hstepA;
    const size_t tstep = 2 * hstep;
    const unsigned ldsw = (unsigned)wid * 1024u;
    const int aoff = lds_byte(wr * 64 + fr, fq * 8), boff = lds_byte(wc * 32 + fr, fq * 8);
#define PG8_SA(b, h) (((b) * 2 + (h)) * HTB)
#define PG8_SB(b, h) ((4 + (b) * 2 + (h)) * HTB)
#define PG8_STAGE(bufoff, gbase, voff) do { _Pragma("unroll") for (int _i = 0; _i < 2; ++_i) \
        __builtin_amdgcn_global_load_lds((const unsigned*)((const char*)(gbase) + (voff)[_i]), (PG8_LAS unsigned*)(lds + (bufoff) + ldsw + _i * 8192), 16, 0, 0); } while (0)
#define PG8_LDA(dst, b, h) do { _Pragma("unroll") for (int m = 0; m < 4; ++m) _Pragma("unroll") for (int k = 0; k < 2; ++k) dst[m][k] = *(const PG8_LAS bf16x8*)(lds + PG8_SA(b, h) + aoff + m * 2048 + k * 1024); } while (0)
#define PG8_LDB(dst, b, h) do { _Pragma("unroll") for (int n = 0; n < 2; ++n) _Pragma("unroll") for (int k = 0; k < 2; ++k) dst[n][k] = *(const PG8_LAS bf16x8*)(lds + PG8_SB(b, h) + boff + n * 2048 + k * 1024); } while (0)
#define PG8_MMA(ai, bj, At, Bt) do { __builtin_amdgcn_s_setprio(1); _Pragma("unroll") for (int m = 0; m < 4; ++m) _Pragma("unroll") for (int n = 0; n < 2; ++n) _Pragma("unroll") for (int k = 0; k < 2; ++k) \
        acc[ai][bj][m][n] = __builtin_amdgcn_mfma_f32_16x16x32_bf16(Bt[n][k], At[m][k], acc[ai][bj][m][n], 0, 0, 0); __builtin_amdgcn_s_setprio(0); } while (0)
#define PG8_WAIT_V(n) asm volatile("s_waitcnt vmcnt(" #n ")" ::: "memory")
#define PG8_WAIT_L(n) asm volatile("s_waitcnt lgkmcnt(" #n ")" ::: "memory")
#define PG8_BAR __builtin_amdgcn_s_barrier()
#define PG8_SCHED __builtin_amdgcn_sched_barrier(0)
    Unit cur, nxt; int ui = 0;
    if (!S.next(0, cur)) return;
    f32x4 acc[2][2][4][2];
#pragma unroll
    for (int a = 0; a < 2; ++a)
#pragma unroll
        for (int b = 0; b < 2; ++b)
#pragma unroll
            for (int m = 0; m < 4; ++m)
#pragma unroll
                for (int n = 0; n < 2; ++n) acc[a][b][m][n] = (f32x4){0.f, 0.f, 0.f, 0.f};
    bf16x8 At[4][2], B0[2][2], B1[2][2];
    const char* cA = (const char*)g.A + (size_t)cur.pm * tstepA; const char* cB = (const char*)g.Bt + (size_t)cur.pn * tstep;
    S.a_ready(cur);
    if constexpr (SP2) {
        PG8_STAGE(PG8_SB(0, 0), cB, voffB); PG8_STAGE(PG8_SB(0, 1), cB + hstep, voffB); PG8_STAGE(PG8_SA(0, 0), cA, voffA); PG8_STAGE(PG8_SA(0, 1), cA + hstepA, voffA);
        if (wr == 1) PG8_BAR;
        PG8_WAIT_V(2); PG8_BAR;
        PG8_STAGE(PG8_SB(1, 0), cB + kstep, voffB); PG8_STAGE(PG8_SA(1, 0), cA + kstep, voffA); PG8_STAGE(PG8_SB(1, 1), cB + hstep + kstep, voffB);
        PG8_WAIT_V(6); PG8_BAR;
    } else {
        PG8_STAGE(PG8_SB(0, 0), cB, voffB); PG8_STAGE(PG8_SA(0, 0), cA, voffA); PG8_STAGE(PG8_SB(0, 1), cB + hstep, voffB); PG8_STAGE(PG8_SA(0, 1), cA + hstepA, voffA);
        if (wr == 1) PG8_BAR;
        PG8_WAIT_V(4); PG8_BAR;
        PG8_STAGE(PG8_SB(1, 0), cB + kstep, voffB); PG8_STAGE(PG8_SA(1, 0), cA + kstep, voffA); PG8_STAGE(PG8_SB(1, 1), cB + hstep + kstep, voffB);
        PG8_WAIT_V(6); PG8_BAR;
    }
    for (;;) {
        const bool has_next = S.next(ui + 1, nxt);
        const char* nA = has_next ? (const char*)g.A + (size_t)nxt.pm * tstepA : cA; const char* nB = has_next ? (const char*)g.Bt + (size_t)nxt.pn * tstep : cB;
        for (int t = 0; t < nt; t += 2) {
            const bool last = (t == nt - 2);
            const char* a1 = cA + (size_t)(t + 1) * kstep;
            const char* a2 = last ? nA : cA + (size_t)(t + 2) * kstep; const char* b2 = last ? nB : cB + (size_t)(t + 2) * kstep;
            const char* a3 = a2 + kstep; const char* b3 = b2 + kstep;
            if (last && has_next) S.a_ready(nxt);
            if constexpr (SP2) {
            PG8_LDB(B0, 0, 0); PG8_LDB(B1, 0, 1); PG8_SCHED; PG8_LDA(At, 0, 0); PG8_STAGE(PG8_SA(1, 1), a1 + hstepA, voffA);
            PG8_WAIT_V(8); PG8_WAIT_L(0); PG8_BAR; PG8_MMA(0, 0, At, B0); PG8_MMA(0, 1, At, B1); PG8_BAR; PG8_SCHED;
            PG8_LDA(At, 0, 1); PG8_STAGE(PG8_SB(0, 0), b2, voffB); PG8_STAGE(PG8_SB(0, 1), b2 + hstep, voffB); PG8_STAGE(PG8_SA(0, 0), a2, voffA);
            PG8_WAIT_V(8); PG8_WAIT_L(0); PG8_BAR; PG8_MMA(1, 0, At, B0); PG8_MMA(1, 1, At, B1); PG8_BAR; PG8_SCHED;
            PG8_LDB(B0, 1, 0); PG8_LDB(B1, 1, 1); PG8_SCHED; PG8_LDA(At, 1, 0); PG8_STAGE(PG8_SA(0, 1), a2 + hstepA, voffA);
            PG8_WAIT_V(8); PG8_WAIT_L(0); PG8_BAR; PG8_MMA(0, 0, At, B0); PG8_MMA(0, 1, At, B1); PG8_BAR; PG8_SCHED;
            PG8_LDA(At, 1, 1); PG8_STAGE(PG8_SB(1, 0), b3, voffB); PG8_STAGE(PG8_SB(1, 1), b3 + hstep, voffB); PG8_STAGE(PG8_SA(1, 0), a3, voffA);
            PG8_WAIT_V(8); PG8_WAIT_L(0); PG8_BAR; PG8_MMA(1, 0, At, B0); PG8_MMA(1, 1, At, B1); PG8_BAR; PG8_SCHED;
            } else {
            PG8_LDB(B0, 0, 0); PG8_SCHED; PG8_LDA(At, 0, 0); PG8_STAGE(PG8_SA(1, 1), a1 + hstepA, voffA);
            PG8_WAIT_L(8); PG8_BAR; PG8_WAIT_L(0); PG8_MMA(0, 0, At, B0); PG8_BAR; PG8_SCHED;
            PG8_LDB(B1, 0, 1); PG8_STAGE(PG8_SB(0, 0), b2, voffB);
            PG8_BAR; PG8_WAIT_L(0); PG8_MMA(0, 1, At, B1); PG8_BAR;
            PG8_LDA(At, 0, 1); PG8_STAGE(PG8_SA(0, 0), a2, voffA);
            PG8_BAR; PG8_WAIT_L(0); PG8_MMA(1, 0, At, B0); PG8_BAR; PG8_SCHED;
            PG8_STAGE(PG8_SB(0, 1), b2 + hstep, voffB);
            PG8_WAIT_V(6); PG8_BAR; PG8_MMA(1, 1, At, B1); PG8_BAR;
            PG8_LDB(B0, 1, 0); PG8_SCHED; PG8_LDA(At, 1, 0); PG8_STAGE(PG8_SA(0, 1), a2 + hstepA, voffA);
            PG8_WAIT_L(8); PG8_BAR; PG8_WAIT_L(0); PG8_MMA(0, 0, At, B0); PG8_BAR; PG8_SCHED;
            PG8_LDB(B1, 1, 1); PG8_STAGE(PG8_SB(1, 0), b3, voffB);
            PG8_BAR; PG8_WAIT_L(0); PG8_MMA(0, 1, At, B1); PG8_BAR;
            PG8_LDA(At, 1, 1); PG8_STAGE(PG8_SA(1, 0), a3, voffA);
            PG8_BAR; PG8_WAIT_L(0); PG8_MMA(1, 0, At, B0); PG8_BAR; PG8_SCHED;
            PG8_STAGE(PG8_SB(1, 1), b3 + hstep, voffB);
            PG8_WAIT_V(6); PG8_BAR; PG8_MMA(1, 1, At, B1); PG8_BAR;
            }
        }
        if constexpr (ALIGN_EPI) { if (wr == 0) PG8_BAR; }
        if constexpr (!Epi::AFTER_DRAIN) { int fr_e = fr, fq_e = fq; asm volatile("" : "+v"(fr_e), "+v"(fq_e));   E(acc, cur, wr, wc, fr_e, fq_e); S.done(cur); }
        if (!has_next) break;
#pragma unroll
        for (int a = 0; a < 2; ++a)
#pragma unroll
            for (int b = 0; b < 2; ++b)
#pragma unroll
                for (int m = 0; m < 4; ++m)
#pragma unroll
                    for (int n = 0; n < 2; ++n) acc[a][b][m][n] = (f32x4){0.f, 0.f, 0.f, 0.f};
        cur = nxt; cA = nA; cB = nB; ++ui;
        if constexpr (ALIGN_EPI) { if (wr == 1) PG8_BAR; }
    }
    PG8_WAIT_V(0);
    if constexpr (!ALIGN_EPI) { if (wr == 0) PG8_BAR; }
    PG8_BAR;
    if constexpr (Epi::AFTER_DRAIN) { E.fused(acc, cur, wr, wc, fr, fq, lds, wid, lane); S.done(cur); }
#undef PG8_SA
#undef PG8_SB
#undef PG8_STAGE
#undef PG8_LDA
#undef PG8_LDB
#undef PG8_MMA
#undef PG8_WAIT_V
#undef PG8_WAIT_L
#undef PG8_BAR
#undef PG8_SCHED
}
}
__device__ __forceinline__ double dexp_(double x) {
    const double k = __builtin_rint(x * 1.4426950408889634);
    const double r = (x - k * 0.693147180369123816490e+00) - k * 1.90821492927058770002e-10;
    double t = 1.0 / 6227020800.0;
    t = t * r + 1.0 / 479001600.0; t = t * r + 1.0 / 39916800.0; t = t * r + 1.0 / 3628800.0; t = t * r + 1.0 / 362880.0; t = t * r + 1.0 / 40320.0;
    t = t * r + 1.0 / 5040.0; t = t * r + 1.0 / 720.0; t = t * r + 1.0 / 120.0; t = t * r + 1.0 / 24.0; t = t * r + 1.0 / 6.0; t = t * r + 0.5; t = t * r + 1.0; t = t * r + 1.0;
    const long long bits = (long long)(1023 + (int)k) << 52;
    return t * __builtin_bit_cast(double, bits);
}
__device__ __forceinline__ void dsincos_(double th, double& s, double& c) {
    const double k = __builtin_rint(th * 0.63661977236758134308);
    const double r = (th - k * 1.57079632673412561417e+00) - k * 6.07710050650619224932e-11;
    const double r2 = r * r;
    double ps = -1.0 / 1307674368000.0; ps = ps * r2 + 1.0 / 6227020800.0; ps = ps * r2 - 1.0 / 39916800.0; ps = ps * r2 + 1.0 / 362880.0; ps = ps * r2 - 1.0 / 5040.0; ps = ps * r2 + 1.0 / 120.0; ps = ps * r2 - 1.0 / 6.0; ps = ps * r2 + 1.0;
    const double sr = ps * r;
    double pc = 1.0 / 20922789888000.0; pc = pc * r2 - 1.0 / 87178291200.0; pc = pc * r2 + 1.0 / 479001600.0; pc = pc * r2 - 1.0 / 3628800.0; pc = pc * r2 + 1.0 / 40320.0; pc = pc * r2 - 1.0 / 720.0; pc = pc * r2 + 1.0 / 24.0; pc = pc * r2 - 0.5; pc = pc * r2 + 1.0;
    const int q = ((int)k) & 3;
    s = (q == 0) ? sr : (q == 1) ? pc : (q == 2) ? -sr : -pc;
    c = (q == 0) ? pc : (q == 1) ? -sr : (q == 2) ? -pc : sr;
}
__device__ __forceinline__ int win_dest_row(int n) {
    if (n < 512) return n;
    if (n < 1024) { const int c = n - 512; return 512 + (c >> 7) * 256 + (c & 127); }
    const int c = n - 1024; return 512 + (c >> 7) * 256 + 128 + (c & 127);
}
__device__ __forceinline__ void p0_transpose_item(const float* W, int K, int N, bf16* WT, bool perm_win, LAS float* scr, int item, int lane) {
    const int nblk = N / 32, kb = item / nblk, nb = item % nblk, k0 = 64 * kb, n0 = 32 * nb;
    const int r0 = perm_win ? win_dest_row(n0) : n0;
#pragma unroll 8
    for (int i = 0; i < 32; ++i) { const int kk = 2 * i + (lane >> 5); scr[kk * 33 + (lane & 31)] = W[(size_t)(k0 + kk) * N + n0 + (lane & 31)]; }
    LDS_WAIT();
    const int c = lane & 7;
#pragma unroll
    for (int j = 0; j < 4; ++j) { const int n = (lane >> 3) + 8 * j; const LAS float* s = scr + (8 * c) * 33 + n;
        v4u o; o.x = pk2(s[0 * 33], s[1 * 33]); o.y = pk2(s[2 * 33], s[3 * 33]); o.z = pk2(s[4 * 33], s[5 * 33]); o.w = pk2(s[6 * 33], s[7 * 33]);
        *(v4u*)(WT + (size_t)(r0 + n) * K + k0 + 8 * c) = o; }
    LDS_WAIT();
}

__device__ __forceinline__ void phase0(const Params& p, LAS unsigned char* lds, int tid, int lane, int wave, int blk, int G) {
    float* mod = (float*)(p.ws + WS_MOD); float* modc = (float*)(p.ws + WS_MODC);
    LAS float* sl = (LAS float*)lds;
    LAS float* scr = (LAS float*)(lds + 57344 + wave * 9216);
    if (blk < 96) {
        for (int e = tid; e < 9 * 1024; e += 512) { const float v = e < 8192 ? p.c[e] : p.c_ctx[e - 8192]; sl[e] = v / (1.0f + expf(-v)); }
        __syncthreads();
        const int n = blk * 64 + lane;
        float acc[9];
#pragma unroll
        for (int j = 0; j < 9; ++j) acc[j] = 0.f;
#pragma unroll 4
        for (int k = wave * 128; k < wave * 128 + 128; k += 4) {
            const float w0 = p.ada_w[(size_t)(k + 0) * 6144 + n], w1 = p.ada_w[(size_t)(k + 1) * 6144 + n], w2 = p.ada_w[(size_t)(k + 2) * 6144 + n], w3 = p.ada_w[(size_t)(k + 3) * 6144 + n];
#pragma unroll
            for (int j = 0; j < 9; ++j) { const f32x4 sv = *(const LAS f32x4*)(sl + j * 1024 + k); acc[j] += (sv[0] * w0 + sv[1] * w1) + (sv[2] * w2 + sv[3] * w3); }
        }
        LAS float* red = (LAS float*)(lds + 36864);
#pragma unroll
        for (int j = 0; j < 9; ++j) red[(wave * 9 + j) * 64 + lane] = acc[j];
        __syncthreads();
        for (int e = tid; e < 9 * 64; e += 512) { const int j = e >> 6, l = e & 63; float sum = 0.f;
#pragma unroll
            for (int w = 0; w < 8; ++w) sum += red[(w * 9 + j) * 64 + l];
            const int nn = blk * 64 + l; const float bb = p.ada_b[nn];
            if (j < 8) mod[(size_t)j * 6144 + nn] = sum + bb; else if (nn < 2048) modc[nn] = sum + bb; }
    } else if (blk < 224) {
        const int q = blk - 96, g = q >> 2, dir = (q >> 1) & 1, th = q & 1, dg = dir * 32 + g;
        LAS f32x2* lAp = (LAS f32x2*)lds;
        LAS f32x2* lBb = lAp + 64 * 17;
        LAS f32x2* lC = lBb + 64 * 16;
        f32x2* APOW = (f32x2*)(p.ws + WS_APOW); f32x2* BB = (f32x2*)(p.ws + WS_BB); float* KT = (float*)(p.ws + WS_KT);
        if (tid < 64) {
            const int pp = tid, e = dg * 64 + pp;
            const double lr = (double)p.lam_re[e], li = (double)p.lam_im[e], dt = dexp_((double)p.log_dt[dg]);
            double ar1 = 1.0, ai1 = 0.0;
            for (int n = 0; n <= 16; ++n) { double sn, cs; dsincos_(li * dt * (double)n, sn, cs); const double mag = dexp_(lr * dt * (double)n);
                const f32x2 ap = (f32x2){(float)(mag * cs), (float)(mag * sn)}; lAp[pp * 17 + n] = ap; if (th == 0) APOW[(size_t)e * 17 + n] = ap;
                if (n == 1) { ar1 = mag * cs; ai1 = mag * sn; } }
            const double den = lr * lr + li * li, nr = ar1 - 1.0;
            const double fr = (nr * lr + ai1 * li) / den, fi = (ai1 * lr - nr * li) / den;
#pragma unroll 4
            for (int h = 0; h < 16; ++h) { const double br = (double)p.b_re[(size_t)e * 16 + h], bi = (double)p.b_im[(size_t)e * 16 + h];
                const f32x2 bb = (f32x2){(float)(fr * br - fi * bi), (float)(fr * bi + fi * br)}; lBb[pp * 16 + h] = bb; if (th == 0) BB[(size_t)e * 16 + h] = bb; }
        }
        for (int e = tid; e < 16 * 64; e += 512) { const int i = e >> 6, pp = e & 63; const size_t idx = (size_t)(dg * 16 + i) * 64 + pp; lC[e] = (f32x2){p.c_re[idx], p.c_im[idx]}; }
        __syncthreads();
        for (int e = tid; e < 8 * 256; e += 512) { const int tau = th * 8 + (e >> 8), i = (e >> 4) & 15, j = e & 15; float acc = 0.f;
#pragma unroll 4
            for (int pp = 0; pp < 64; ++pp) { const f32x2 C = lC[i * 64 + pp], A = lAp[pp * 17 + tau], B = lBb[pp * 16 + j];
                const float car = C[0] * A[0] - C[1] * A[1], cai = C[0] * A[1] + C[1] * A[0]; acc += car * B[0] - cai * B[1]; }
            KT[(size_t)(dg * 16 + tau) * 256 + i * 16 + j] = acc; }
    }
    const int gw = blk * 8 + wave, NGW = G * 8;
    constexpr int I_IN = 16 * 48, I_GLU = 8 * 16, I_OUT = 16 * 32, I_1 = 16 * 128, I_2 = 64 * 32, NIT = I_IN + I_GLU + I_OUT + I_1 + I_2;
    for (int it = gw; it < NIT; it += NGW) {
        int r = it;
        if (r < I_IN) { p0_transpose_item(p.w_in, 1024, 1536, (bf16*)(p.ws + WS_WIN), true, scr, r, lane); continue; } r -= I_IN;
        if (r < I_GLU) { p0_transpose_item(p.w_glu, 512, 512, (bf16*)(p.ws + WS_WGLU), false, scr, r, lane); continue; } r -= I_GLU;
        if (r < I_OUT) { p0_transpose_item(p.w_out, 1024, 1024, (bf16*)(p.ws + WS_WOUT), false, scr, r, lane); continue; } r -= I_OUT;
        if (r < I_1) { p0_transpose_item(p.w1, 1024, 4096, (bf16*)(p.ws + WS_W1), false, scr, r, lane); continue; } r -= I_1;
        p0_transpose_item(p.w2, 4096, 1024, (bf16*)(p.ws + WS_W2), false, scr, r, lane);
    }
}

__device__ __forceinline__ void phase1(const Params& p, LAS unsigned char* lds, int tid, int lane, int wave, int blk, int G) {
    const float* mod = (const float*)(p.ws + WS_MOD); const float* modc = (const float*)(p.ws + WS_MODC);
    if (blk < 64) {
        const int n = blk * 64 + lane; float acc[8];
#pragma unroll
        for (int b = 0; b < 8; ++b) acc[b] = 0.f;
        for (int k = wave * 128; k < wave * 128 + 128; ++k) { const float w = p.w1[(size_t)k * DFF + n];
#pragma unroll
            for (int b = 0; b < 8; ++b) acc[b] += mod[(size_t)b * 6144 + 3072 + k] * w; }
        LAS float* red = (LAS float*)lds;
#pragma unroll
        for (int b = 0; b < 8; ++b) red[(wave * 8 + b) * 64 + lane] = acc[b];
        __syncthreads();
        { const int b = tid >> 6; float s = 0.f;
#pragma unroll
          for (int w = 0; w < 8; ++w) s += red[(w * 8 + b) * 64 + lane];
          ((float*)(p.ws + WS_BIAS1))[(size_t)b * DFF + blk * 64 + lane] = s; }
    }
    bf16* A1 = (bf16*)(p.ws + WS_A1);
    const int gw = blk * 8 + wave, NGW = G * 8, per = (MT + NGW - 1) / NGW;
    const int m0 = gw * per, m1 = (m0 + per < MT) ? m0 + per : MT;
    int cur = -1; f32x4 wv[4], sv[4];
    for (int m = m0; m < m1; ++m) {
        const int bsel = m < ML ? (m >> 12) : 8;
        if (bsel != cur) { cur = bsel; const float* sh = bsel < 8 ? mod + (size_t)bsel * 6144 : modc; const float* sc = sh + 1024;
#pragma unroll
            for (int j = 0; j < 4; ++j) { const int c = 4 * lane + 256 * j; wv[j] = *(const f32x4*)(p.norm1_g + c) * (*(const f32x4*)(sc + c) + 1.0f); sv[j] = *(const f32x4*)(sh + c); } }
        const float* xr = m < ML ? p.x + (size_t)m * DM : p.ctx + (size_t)(m - ML) * DM;
        f32x4 v[4]; float ss = 0.f;
#pragma unroll
        for (int j = 0; j < 4; ++j) { v[j] = __builtin_nontemporal_load((const f32x4*)(xr + 4 * lane + 256 * j)); ss += (v[j][0] * v[j][0] + v[j][1] * v[j][1]) + (v[j][2] * v[j][2] + v[j][3] * v[j][3]); }
        const float rstd = rsqrtf(wave_sum(ss) * (1.0f / DM) + EPS_RMS);
#pragma unroll
        for (int j = 0; j < 4; ++j) { const int c = 4 * lane + 256 * j;
            const f32x4 o = v[j] * rstd * wv[j] + sv[j];
            v2u w; w.x = pk2(o[0], o[1]); w.y = pk2(o[2], o[3]);
            *(v2u*)(A1 + (size_t)m * DM + c) = w; }
    }
}

__device__ __forceinline__ void s5_tables(const Params& p, int tid, int blk, int G) {
    const f32x2* APOW = (const f32x2*)(p.ws + WS_APOW); const f32x2* BB = (const f32x2*)(p.ws + WS_BB); const float* KT = (const float*)(p.ws + WS_KT);
    bf16* WT = (bf16*)(p.ws + WS_WT); bf16* MET = (bf16*)(p.ws + WS_MET);
    for (int it = blk * 512 + tid; it < 262144 + 524288; it += G * 512) {
        float v[8];
        if (it < 262144) {
            const int g = it >> 13, n = (it >> 5) & 255, k0 = (it & 31) * 8, dir = n >> 7, part = (n >> 6) & 1, pp = n & 63, s = k0 >> 4, j0 = k0 & 15;
            const int e = dir ? s : 15 - s; const size_t sp = (size_t)(dir * 32 + g) * 64 + pp;
            const f32x2 A = APOW[sp * 17 + e];
#pragma unroll
            for (int jj = 0; jj < 8; ++jj) { const f32x2 B = BB[sp * 16 + j0 + jj]; v[jj] = part ? (A[0] * B[1] + A[1] * B[0]) : (A[0] * B[0] - A[1] * B[1]); }
            v4u o; o.x = pk2(v[0], v[1]); o.y = pk2(v[2], v[3]); o.z = pk2(v[4], v[5]); o.w = pk2(v[6], v[7]);
            *(v4u*)(WT + ((size_t)(g * 256 + n)) * 256 + k0) = o;
        } else {
            const int it2 = it - 262144, g = it2 >> 14, o_ = (it2 >> 6) & 255, k0 = (it2 & 63) * 8, tl = o_ >> 4, i = o_ & 15;
            if (k0 < 256) {
                const int s = k0 >> 4, j0 = k0 & 15;
#pragma unroll
                for (int jj = 0; jj < 8; ++jj) { const int j = j0 + jj; float a = 0.f;
                    if (s <= tl) a += KT[(size_t)((0 * 32 + g) * 16 + (tl - s)) * 256 + i * 16 + j];
                    if (s >= tl) a += KT[(size_t)((1 * 32 + g) * 16 + (s - tl)) * 256 + i * 16 + j];
                    if (s == tl && i == j) a += p.s5_d[g * 16 + i];
                    v[jj] = a; }
            } else {
                const int kk = k0 - 256, dir = kk >> 7, part = (kk >> 6) & 1, p0 = kk & 63, e = dir ? 16 - tl : tl + 1;
#pragma unroll
                for (int jj = 0; jj < 8; ++jj) { const int pp = p0 + jj; const size_t ci = (size_t)((dir * 32 + g) * 16 + i) * 64 + pp;
                    const float cr = p.c_re[ci], cim = p.c_im[ci]; const f32x2 A = APOW[((size_t)(dir * 32 + g) * 64 + pp) * 17 + e];
                    v[jj] = part ? -(cr * A[1] + cim * A[0]) : (cr * A[0] - cim * A[1]); }
            }
            v4u o; o.x = pk2(v[0], v[1]); o.y = pk2(v[2], v[3]); o.z = pk2(v[4], v[5]); o.w = pk2(v[6], v[7]);
            *(v4u*)(MET + ((size_t)(g * 256 + o_)) * 512 + k0) = o;
        }
    }
}

__device__ __forceinline__ void s5_scan_item(const Params& p, LAS unsigned char* lds, int item, int tid, int lane, int wave) {
    const int g = item & 31;
    const bf16* XC = (const bf16*)(p.ws + WS_XC) + (size_t)item * 16 * 256;
    const bf16* WT = (const bf16*)(p.ws + WS_WT) + (size_t)g * 256 * 256;
    const f32x2* APOW = (const f32x2*)(p.ws + WS_APOW);
    LAS float* Sc = (LAS float*)lds;
    LAS f32x2* Tseg = (LAS f32x2*)(lds + 16384);
    LAS f32x2* H0 = Tseg + 512;
    {
        f32x4 acc0 = (f32x4){0.f, 0.f, 0.f, 0.f}, acc1 = acc0; const int r = lane & 15, kg = lane >> 4;
#pragma unroll
        for (int ks = 0; ks < 8; ++ks) { const pg8::bf16x8 a = *(const pg8::bf16x8*)(XC + r * 256 + ks * 32 + kg * 8);
            const pg8::bf16x8 b0 = *(const pg8::bf16x8*)(WT + (size_t)((2 * wave) * 16 + r) * 256 + ks * 32 + kg * 8), b1 = *(const pg8::bf16x8*)(WT + (size_t)((2 * wave + 1) * 16 + r) * 256 + ks * 32 + kg * 8);
            acc0 = __builtin_amdgcn_mfma_f32_16x16x32_bf16(a, b0, acc0, 0, 0, 0); acc1 = __builtin_amdgcn_mfma_f32_16x16x32_bf16(a, b1, acc1, 0, 0, 0); }
#pragma unroll
        for (int j = 0; j < 4; ++j) { Sc[(kg * 4 + j) * 256 + (2 * wave) * 16 + r] = acc0[j]; Sc[(kg * 4 + j) * 256 + (2 * wave + 1) * 16 + r] = acc1[j]; }
    }
    __syncthreads();
    const int sp = tid & 127, dir = sp >> 6, pp = sp & 63, seg = tid >> 7;
    const f32x2 a16 = APOW[((size_t)(dir * 32 + g) * 64 + pp) * 17 + 16];
    const int c0 = dir ? 255 - seg * 64 : seg * 64, cstep = dir ? -1 : 1;
    const float* Sp = (const float*)(p.ws + WS_S) + (size_t)item * 65536 + (size_t)c0 * 256 + dir * 128 + pp;
    float sr[64], si[64];
#pragma unroll
    for (int q = 0; q < 64; ++q) { sr[q] = Sp[q * cstep * 256]; si[q] = Sp[q * cstep * 256 + 64]; }
    {
        float hr = 0.f, hi = 0.f;
#pragma unroll
        for (int q = 0; q < 64; ++q) { const float nr = a16[0] * hr - a16[1] * hi + sr[q], ni = a16[0] * hi + a16[1] * hr + si[q]; hr = nr; hi = ni; }
        Tseg[seg * 128 + sp] = (f32x2){hr, hi};
        if (seg == 0) { float cr = 0.f, ci = 0.f;
#pragma unroll 4
            for (int q = 0; q < 16; ++q) { const int cc = dir ? 15 - q : q; const float xr = Sc[cc * 256 + dir * 128 + pp], xi = Sc[cc * 256 + dir * 128 + 64 + pp];
                const float nr = a16[0] * cr - a16[1] * ci + xr, ni = a16[0] * ci + a16[1] * cr + xi; cr = nr; ci = ni; }
            H0[sp] = (f32x2){cr, ci}; }
    }
    __syncthreads();
    {
        f32x2 a64 = a16;
#pragma unroll
        for (int i = 0; i < 6; ++i) a64 = (f32x2){a64[0] * a64[0] - a64[1] * a64[1], 2.f * a64[0] * a64[1]};
        f32x2 h = H0[sp];
        for (int s2 = 0; s2 < seg; ++s2) { const f32x2 T = Tseg[s2 * 128 + sp]; h = (f32x2){a64[0] * h[0] - a64[1] * h[1] + T[0], a64[0] * h[1] + a64[1] * h[0] + T[1]}; }
        bf16* Xh = (bf16*)(p.ws + WS_X) + (size_t)item * 256 * 512 + (size_t)c0 * 512 + 256 + dir * 128 + pp;
        float hr = h[0], hi = h[1];
#pragma unroll
        for (int q = 0; q < 64; ++q) {
            Xh[q * cstep * 512] = (bf16)f2bf(hr); Xh[q * cstep * 512 + 64] = (bf16)f2bf(hi);
            const float nr = a16[0] * hr - a16[1] * hi + sr[q], ni = a16[0] * hi + a16[1] * hr + si[q]; hr = nr; hi = ni; }
    }
    asm volatile("s_waitcnt vmcnt(0)" ::: "memory");
    __syncthreads();
}

__device__ __forceinline__ void conv_item(const Params& p, const LAS float* cw, int item, int lane) {
    const bf16* HC = (const bf16*)(p.ws + WS_HC); bf16* YC = (bf16*)(p.ws + WS_YC);
    const int rb = item & 7, w = (item >> 3) & 63, b = item >> 9;
    float acc[8][8];
#pragma unroll
    for (int i = 0; i < 8; ++i)
#pragma unroll
        for (int j = 0; j < 8; ++j) acc[i][j] = 0.f;
    const size_t base = ((size_t)b * SEQ + w) * 512 + lane * 8;
#pragma unroll 1
    for (int d = -15; d <= 22; ++d) {
        const int rin = rb * 8 + d;
        if (rin >= 0 && rin < 64) {
            const v4u hv = *(const v4u*)(HC + base + (size_t)rin * 64 * 512);
            const float h[8] = {bflo(hv.x), bfhi(hv.x), bflo(hv.y), bfhi(hv.y), bflo(hv.z), bfhi(hv.z), bflo(hv.w), bfhi(hv.w)};
            const LAS float* wp = cw + (d + 22) * 512 + lane * 8;
#pragma unroll
            for (int ro = 0; ro < 8; ++ro) { const f32x4 w0 = *(const LAS f32x4*)(wp - ro * 512), w1 = *(const LAS f32x4*)(wp - ro * 512 + 4);
#pragma unroll
                for (int j = 0; j < 4; ++j) { acc[ro][j] += h[j] * w0[j]; acc[ro][4 + j] += h[4 + j] * w1[j]; } }
        }
    }
    const f32x4 cb0 = *(const f32x4*)(p.conv_b + lane * 8), cb1 = *(const f32x4*)(p.conv_b + lane * 8 + 4);
    const f32x4 lg0 = *(const f32x4*)(p.ln_g + lane * 8), lg1 = *(const f32x4*)(p.ln_g + lane * 8 + 4);
    const f32x4 lb0 = *(const f32x4*)(p.ln_b + lane * 8), lb1 = *(const f32x4*)(p.ln_b + lane * 8 + 4);
#pragma unroll
    for (int ro = 0; ro < 8; ++ro) {
        float v[8]; float s = 0.f;
#pragma unroll
        for (int j = 0; j < 4; ++j) { v[j] = acc[ro][j] + cb0[j]; v[4 + j] = acc[ro][4 + j] + cb1[j]; }
#pragma unroll
        for (int j = 0; j < 8; ++j) s += v[j];
        const float mean = wave_sum(s) * (1.0f / 512.0f); float qq = 0.f;
#pragma unroll
        for (int j = 0; j < 8; ++j) { v[j] -= mean; qq += v[j] * v[j]; }
        const float rstd = rsqrtf(wave_sum(qq) * (1.0f / 512.0f) + EPS_LN);
        float o[8];
#pragma unroll
        for (int j = 0; j < 4; ++j) { const float y0 = v[j] * rstd * lg0[j] + lb0[j], y1 = v[4 + j] * rstd * lg1[j] + lb1[j]; o[j] = y0 * sigmoidf_(y0); o[4 + j] = y1 * sigmoidf_(y1); }
        v4u ov; ov.x = pk2(o[0], o[1]); ov.y = pk2(o[2], o[3]); ov.z = pk2(o[4], o[5]); ov.w = pk2(o[6], o[7]);
        *(v4u*)(YC + ((size_t)b * SEQ + (rb * 8 + ro) * 64 + w) * 1024 + 512 + lane * 8) = ov;
    }
}

__device__ __forceinline__ void phase_conv(const Params& p, LAS unsigned char* lds, int tid, int lane, int wave, int blk, int G) {
    LAS float* cw = (LAS float*)lds;
    for (int e = tid; e < 45 * 512; e += 512) { const int kk = e >> 9; cw[e] = (kk >= 7 && kk <= 37) ? p.conv_w[e - 7 * 512] : 0.f; }
    __syncthreads();
    for (int item = blk * 8 + wave; item < 4096; item += G * 8) conv_item(p, cw, item, lane);
}
__device__ __forceinline__ void phase_final(const Params& p, int lane, int wave, int blk, int G) {
    const int gw = blk * 8 + wave, NGW = G * 8;
    for (int m = gw; m < ML; m += NGW) {
        float* o = p.out + (size_t)m * DM; f32x4 v[4]; float ss = 0.f;
#pragma unroll
        for (int j = 0; j < 4; ++j) { v[j] = *(const f32x4*)(o + 4 * lane + 256 * j); ss += (v[j][0] * v[j][0] + v[j][1] * v[j][1]) + (v[j][2] * v[j][2] + v[j][3] * v[j][3]); }
        const float rstd = rsqrtf(wave_sum(ss) * (1.0f / DM) + EPS_RMS);
#pragma unroll
        for (int j = 0; j < 4; ++j) { const f32x4 g = *(const f32x4*)(p.final_g + 4 * lane + 256 * j); *(f32x4*)(o + 4 * lane + 256 * j) = v[j] * rstd * g; }
    }
}

#ifndef ALIGN_OUT
#define ALIGN_OUT true
#endif
#ifndef ALIGN_UP
#define ALIGN_UP true
#endif
#ifndef ALIGN_DOWN
#define ALIGN_DOWN true
#endif
#ifndef ALIGN_G1
#define ALIGN_G1 true
#endif
#ifndef REP_P0
#define REP_P0 1
#endif
#ifndef REP_P1
#define REP_P1 1
#endif
#ifndef REP_G1
#define REP_G1 1
#endif
#ifndef REP_S5A
#define REP_S5A 1
#endif
#ifndef REP_CONV
#define REP_CONV 1
#endif
#ifndef REP_S5C
#define REP_S5C 1
#endif
#ifndef REP_GLU
#define REP_GLU 1
#endif
#ifndef REP_OUT
#define REP_OUT 1
#endif
#ifndef REP_UP
#define REP_UP 1
#endif
#ifndef REP_DOWN
#define REP_DOWN 1
#endif
#ifndef NSYNC_EXTRA
#define NSYNC_EXTRA 0
#endif
__global__ void __launch_bounds__(512, 2) fwd_kernel(Params p) {
    extern __shared__ __attribute__((aligned(16))) unsigned char lds_raw[];
    cg::grid_group grid = cg::this_grid();
    LAS unsigned char* lds = (LAS unsigned char*)lds_raw;
    const int blk = blockIdx.x, G = gridDim.x;
#define TIDX ((int)threadIdx.x)
#define TL int t_ = TIDX; asm volatile("" : "+v"(t_)); const int tid = t_, lane = t_ & 63, wave = __builtin_amdgcn_readfirstlane(t_ >> 6); (void)tid; (void)lane; (void)wave;
    unsigned char* ws = p.ws;
    if (threadIdx.x < 2) ((volatile LAS unsigned*)(lds + LDS_MISC))[threadIdx.x] = 0u;
    if (blk == 0) for (int e = threadIdx.x; e < XCD_BAR_WORDS; e += 512) ((unsigned*)(ws + WS_BAR))[e] = 0u;
    __syncthreads();

    for (int rep = 0; rep < REP_P0; ++rep)
    { TL phase0(p, lds, tid, lane, wave, blk, G); }
    grid.sync();
    const XcdBarrier xbar = xcd_barrier_post((unsigned*)(ws + WS_BAR), (volatile LAS unsigned*)(lds + LDS_MISC));
    for (int rep = 0; rep < REP_P1; ++rep) {
    { TL phase1(p, lds, tid, lane, wave, blk, G); }
    }
    for (int rep = 0; rep < NSYNC_EXTRA; ++rep) xcd_barrier(xbar);
    xcd_barrier(xbar);
    for (int rep = 0; rep < REP_G1; ++rep)
    {
        pg8::Gemm g{(const bf16*)(ws + WS_A1), (const bf16*)(ws + WS_WIN), MT, INC, DM, DM}; pg8::G1Order S; S.init(G, blk);
        pg8::EpiG1 E{(bf16*)(ws + WS_X), (bf16*)(ws + WS_XC), (bf16*)(ws + WS_HC)};
        pg8::gemm_phase<pg8::EpiG1, pg8::G1Order, ALIGN_G1, true>(lds, g, S, E, TIDX);
        if (blk >= 16 && G > 16) { TL s5_tables(p, tid, blk - 16, G - 16); }
    }
    xcd_barrier(xbar);
    for (int rep = 0; rep < REP_S5A; ++rep)
    for (int item = blk; item < 256; item += G) {
        {
            pg8::Gemm g{(const bf16*)(ws + WS_X), (const bf16*)(ws + WS_WT), 65536, 256, 256, 512}; pg8::OneUnit S{item, item & 31};
            pg8::EpiS5A E{(float*)(ws + WS_S)};
            pg8::gemm_phase<pg8::EpiS5A, pg8::OneUnit, true, true>(lds, g, S, E, TIDX);
        }
        asm volatile("s_waitcnt vmcnt(0)" ::: "memory"); __syncthreads();
        { TL s5_scan_item(p, lds, item, tid, lane, wave); }
        pg8::Gemm g{(const bf16*)(ws + WS_X), (const bf16*)(ws + WS_MET), 65536, 256, 512, 512}; pg8::OneUnit S{item, item & 31};
        pg8::EpiS5C E{(bf16*)(ws + WS_G)};
        pg8::gemm_phase<pg8::EpiS5C, pg8::OneUnit, true, true>(lds, g, S, E, TIDX);
    }
    for (int rep = 0; rep < REP_CONV; ++rep)
    { TL phase_conv(p, lds, tid, lane, wave, blk, G); }
    xcd_barrier(xbar);
    for (int rep = 0; rep < REP_GLU; ++rep)
    {
        pg8::Gemm g{(const bf16*)(ws + WS_G), (const bf16*)(ws + WS_WGLU), ML, S5W, S5W, S5W}; pg8::StaticOrder S; S.init(ML, S5W, G, blk);
        pg8::EpiGlu E{(const bf16*)(ws + WS_G), (bf16*)(ws + WS_YC)};
        pg8::gemm_phase<pg8::EpiGlu, pg8::StaticOrder, true, true>(lds, g, S, E, TIDX);
    }
    xcd_barrier(xbar);
    for (int rep = 0; rep < REP_OUT; ++rep)
    {
        pg8::Gemm g{(const bf16*)(ws + WS_YC), (const bf16*)(ws + WS_WOUT), ML, DM, DM, DM}; pg8::StaticOrder S; S.init(ML, DM, G, blk);
        pg8::EpiOut E{p.x, (const float*)(ws + WS_MOD), p.norm2_g, (float*)(ws + WS_H1), (bf16*)(ws + WS_HS), (float*)(ws + WS_SS1)};
        pg8::gemm_phase<pg8::EpiOut, pg8::StaticOrder, ALIGN_OUT, true>(lds, g, S, E, TIDX);
    }
    xcd_barrier(xbar);
    for (int rep = 0; rep < REP_UP; ++rep)
    {
        pg8::Gemm g{(const bf16*)(ws + WS_HS), (const bf16*)(ws + WS_W1), ML, DFF, DM, DM}; pg8::StaticOrder S; S.init(ML, DFF, G, blk);
        pg8::EpiUp E{(const float*)(ws + WS_SS1), (const float*)(ws + WS_BIAS1), (bf16*)(ws + WS_HID)};
        pg8::gemm_phase<pg8::EpiUp, pg8::StaticOrder, ALIGN_UP, true>(lds, g, S, E, TIDX);
    }
    xcd_barrier(xbar);
    for (int rep = 0; rep < REP_DOWN; ++rep)
    {
        pg8::Gemm g{(const bf16*)(ws + WS_HID), (const bf16*)(ws + WS_W2), ML, DM, DFF, DFF}; pg8::StaticOrder S; S.init(ML, DM, G, blk);
        pg8::EpiDown E{(const float*)(ws + WS_H1), (const float*)(ws + WS_MOD), p.out};
        pg8::gemm_phase<pg8::EpiDown, pg8::StaticOrder, ALIGN_DOWN, true>(lds, g, S, E, TIDX);
    }
    xcd_barrier(xbar);
    { TL phase_final(p, lane, wave, blk, G); }
}

extern "C" void kernel_launch(void* const* d_in, const int* in_sizes, int n_in, void* d_out, int out_size, void* d_ws, size_t ws_size, hipStream_t stream) {
    static int grid = 0;
    if (grid == 0) {
        if (n_in != 26 || out_size != ML * DM || ws_size < WS_END) { fprintf(stderr, "kernel_launch: unexpected shapes (n_in %d out %d ws %zu)\n", n_in, out_size, ws_size); grid = -1; return; }
        int dev = 0, cus = 0, per_cu = 0;
        hipGetDevice(&dev);
        hipDeviceGetAttribute(&cus, hipDeviceAttributeMultiprocessorCount, dev);
        if (hipFuncSetAttribute((const void*)fwd_kernel, hipFuncAttributeMaxDynamicSharedMemorySize, LDS_BYTES) != hipSuccess) { fprintf(stderr, "kernel_launch: hipFuncSetAttribute failed\n"); grid = -1; return; }
        if (hipOccupancyMaxActiveBlocksPerMultiprocessor(&per_cu, (const void*)fwd_kernel, 512, LDS_BYTES) != hipSuccess || per_cu < 1) { fprintf(stderr, "kernel_launch: occupancy query says %d\n", per_cu); per_cu = 1; (void)hipGetLastError(); }
        grid = cus * per_cu;
    }
    if (grid < 0) return;
    Params p{};
    const float** f = (const float**)&p;
    for (int i = 0; i < 26; ++i) f[i] = (const float*)d_in[i];
    p.out = (float*)d_out; p.ws = (unsigned char*)d_ws;
    void* args[] = {&p};
    hipError_t e = hipLaunchCooperativeKernel((const void*)fwd_kernel, dim3(grid), dim3(512), args, LDS_BYTES, stream);
    if (e != hipSuccess) fprintf(stderr, "cooperative launch failed: %s (grid %d)\n", hipGetErrorString(e), grid);
}
```
